# Optimizing an MI355X kernel written in HIP

```python
import jax, jax.numpy as jnp
from jax import lax

D_MODEL = 1024
BATCH = 32
SEQ = 256
DEPTH = 2
DEC_BATCH = 4
DEC_SEQ = 1024
PAST_LEN = 256

GRID_W = 64
MIX_W = D_MODEL
CONV_W = D_MODEL // 4
CONV_K = 3
LRU_W = D_MODEL // 4
LRU_BLOCKS = 4
LRU_BLK = LRU_W // LRU_BLOCKS
LRU_CONV_K = 4
LRU_C = 8.0
MLA_HEADS = 8
QK_NOPE = 64
QK_ROPE = 32
V_DIM = 64
QK_DIM = QK_NOPE + QK_ROPE
MLA_W = MLA_HEADS * V_DIM
Q_LORA = 256
KV_LORA = 128
ROPE_THETA = 10000.0
FF = ((8 * D_MODEL // 3 + 255) // 256) * 256
Q_BLOCK = 128
SPLIT_CONV = 3 * CONV_W
SPLIT_LRU = SPLIT_CONV + 2 * LRU_W
SPLIT_Q = SPLIT_LRU + Q_LORA
SPLIT_KV = SPLIT_Q + KV_LORA
IN_W = SPLIT_KV + QK_ROPE
EPS = 1e-6

kernel_name = 'hybrid_diffusion_prefix_step'


def rms_norm(x, g):
    xf = x.astype(jnp.float32)
    y = xf * lax.rsqrt(jnp.mean(xf * xf, axis=-1, keepdims=True) + EPS)
    return (y * g.astype(jnp.float32)).astype(x.dtype)


def dwconv(x, w, b, pad_left, pad_right):
    C = x.shape[-1]
    y = lax.conv_general_dilated(x, w.astype(x.dtype)[:, None, :], window_strides=(1,),
                                 padding=[(pad_left, pad_right)],
                                 dimension_numbers=('NWC', 'WIO', 'NWC'),
                                 feature_group_count=C)
    return y + b.astype(x.dtype)


def short_conv_mixer(u, w, b):
    bg, cg, h = jnp.split(u, 3, axis=-1)
    return bg * dwconv(cg * h, w, b, 1, 1)


def block_diag_linear(x, w, b):
    Bsz, S, _ = x.shape
    xb = x.reshape(Bsz, S, LRU_BLOCKS, LRU_BLK)
    return jnp.einsum('bsnk,nkj->bsnj', xb, w).reshape(Bsz, S, LRU_W) + b


def _lin_combine(left, right):
    a1, b1 = left
    a2, b2 = right
    return a1 * a2, a2 * b1 + b2


def rglru_scan(x, wa, ba, wi, bi, lam, h0, reverse):
    xf = x.astype(jnp.float32)
    r = jax.nn.sigmoid(block_diag_linear(xf, wa, ba).astype(jnp.float32))
    i = jax.nn.sigmoid(block_diag_linear(xf, wi, bi).astype(jnp.float32))
    log_a = -LRU_C * r * jax.nn.softplus(-lam.astype(jnp.float32))
    a = jnp.exp(log_a)
    bt = jnp.sqrt(-jnp.expm1(2.0 * log_a)) * (i * xf)
    edge = -1 if reverse else 0
    bt = bt.at[:, edge].add(a[:, edge] * h0.astype(jnp.float32))
    _, h = lax.associative_scan(_lin_combine, (a, bt), axis=1, reverse=reverse)
    return h


def rglru_mixer(u, lp, h0f, h0b):
    xb, yb = jnp.split(u, 2, axis=-1)
    xc = dwconv(xb, lp['lru_conv_w'], lp['lru_conv_b'], 2, 1)
    hf = rglru_scan(xc, lp['lru_wa'][0], lp['lru_ba'][0], lp['lru_wi'][0], lp['lru_bi'][0],
                    lp['lru_lambda'][0], h0f, False)
    hb = rglru_scan(xc, lp['lru_wa'][1], lp['lru_ba'][1], lp['lru_wi'][1], lp['lru_bi'][1],
                    lp['lru_lambda'][1], h0b, True)
    y = ((hf + hb) * jax.nn.gelu(yb.astype(jnp.float32))).astype(u.dtype)
    return y, hf[:, -1].astype(u.dtype), hb[:, 0].astype(u.dtype)


def axial_rope_tables(n_tokens):
    n_rows = n_tokens // GRID_W
    row = jnp.repeat(jnp.arange(n_rows, dtype=jnp.float32), GRID_W)
    col = jnp.tile(jnp.arange(GRID_W, dtype=jnp.float32), n_rows)
    n_freq = QK_ROPE // 4
    inv_freq = jnp.power(ROPE_THETA, -jnp.arange(n_freq, dtype=jnp.float32) / n_freq)
    ang = jnp.stack([row[:, None] * inv_freq, col[:, None] * inv_freq], axis=1)
    return jnp.cos(ang), jnp.sin(ang)


def apply_axial_rope(x, cos, sin):
    n_freq = QK_ROPE // 4
    xs = x.astype(jnp.float32).reshape(x.shape[:-1] + (2, 2, n_freq))
    x1 = xs[..., 0, :]
    x2 = xs[..., 1, :]
    c = cos[None, :, None]
    s = sin[None, :, None]
    y = jnp.stack([x1 * c - x2 * s, x2 * c + x1 * s], axis=-2)
    return y.reshape(x.shape).astype(x.dtype)


def mla_queries(u_q, lp, rope):
    Bsz, S, _ = u_q.shape
    q = (rms_norm(u_q, lp['mla_qnorm_g']) @ lp['mla_wq_up']).reshape(Bsz, S, MLA_HEADS, QK_DIM)
    q = rms_norm(q, lp['q_norm_g'])
    if rope is not None:
        q = jnp.concatenate([q[..., :QK_NOPE], apply_axial_rope(q[..., QK_NOPE:], *rope)], axis=-1)
    return q


def mla_keys_values(ckv, k_rope, lp, rope):
    Bsz, S, _ = ckv.shape
    kv = (ckv @ lp['mla_wkv_up']).reshape(Bsz, S, MLA_HEADS, QK_NOPE + V_DIM)
    k_nope, v = kv[..., :QK_NOPE], kv[..., QK_NOPE:]
    k_r = jnp.broadcast_to(k_rope[:, :, None, :], (Bsz, S, MLA_HEADS, QK_ROPE)).astype(k_nope.dtype)
    k = rms_norm(jnp.concatenate([k_nope, k_r], axis=-1), lp['k_norm_g'])
    if rope is not None:
        k = jnp.concatenate([k[..., :QK_NOPE], apply_axial_rope(k[..., QK_NOPE:], *rope)], axis=-1)
    return k, v


def attend(q, k, v):
    Bsz, Sq, H, Dk = q.shape
    nb = Sq // Q_BLOCK
    qb = q.reshape(Bsz, nb, Q_BLOCK, H, Dk).transpose(1, 0, 2, 3, 4)
    scale = Dk ** -0.5

    def one(qblk):
        s = jnp.einsum('bqhd,bkhd->bhqk', qblk, k).astype(jnp.float32) * scale
        p = jax.nn.softmax(s, axis=-1).astype(v.dtype)
        return jnp.einsum('bhqk,bkhd->bqhd', p, v)

    o = lax.map(one, qb)
    return o.transpose(1, 0, 2, 3, 4).reshape(Bsz, Sq, H * v.shape[-1])


def mixing(hn, lp, rope, ctx_ckv, ctx_kr, h0f, h0b):
    u = hn @ lp['w_in']
    u_conv, u_lru, u_q, u_ckv, u_kr = jnp.split(u, [SPLIT_CONV, SPLIT_LRU, SPLIT_Q, SPLIT_KV], axis=-1)
    y_conv = short_conv_mixer(u_conv, lp['conv_w'], lp['conv_b'])
    y_lru, hf_last, hb_first = rglru_mixer(u_lru, lp, h0f, h0b)
    ckv = rms_norm(u_ckv, lp['mla_kvnorm_g'])
    q = mla_queries(u_q, lp, rope)
    k, v = mla_keys_values(ckv, u_kr, lp, rope)
    if ctx_ckv is not None:
        k_c, v_c = mla_keys_values(ctx_ckv.astype(ckv.dtype), ctx_kr, lp, None)
        k = jnp.concatenate([k, k_c], axis=1)
        v = jnp.concatenate([v, v_c], axis=1)
    y_mla = attend(q, k, v)
    y = jnp.concatenate([rms_norm(y_conv, lp['gnorm_conv']),
                         rms_norm(y_lru, lp['gnorm_lru']),
                         rms_norm(y_mla, lp['gnorm_mla'])], axis=-1) @ lp['w_out']
    return y, ckv, u_kr, hf_last, hb_first


def trunk_layer(x, cond, lp, rope, ctx_ckv, ctx_kr, h0f, h0b):
    mod = (jax.nn.silu(cond) @ lp['ada_w'] + lp['ada_b'])[:, None, :]
    sh1, sc1, g1, sh2, sc2, g2 = jnp.split(mod, 6, axis=-1)
    hn = rms_norm(x, lp['norm1_g']) * (1 + sc1) + sh1
    y, ckv, kr, hf, hb = mixing(hn, lp, rope, ctx_ckv, ctx_kr, h0f, h0b)
    x = x + g1 * y
    hn = rms_norm(x, lp['norm2_g']) * (1 + sc2) + sh2
    ff = (jax.nn.silu(hn @ lp['w_gate']) * (hn @ lp['w_up'])) @ lp['w_down']
    x = x + g2 * ff
    return x, ckv, kr, hf, hb


def _w(k, shape, fan_in, scale=1.0):
    return jax.random.normal(k, shape, jnp.float32) * (scale * fan_in ** -0.5)


def _g(k, shape):
    return 1.0 + 0.02 * jax.random.normal(k, shape, jnp.float32)


def _b(k, shape):
    return 0.02 * jax.random.normal(k, shape, jnp.float32)


def setup_inputs(seed: int = 0) -> dict:
    key = jax.random.key(seed)
    ks = jax.random.split(key, 40)
    a_init = jax.random.uniform(ks[19], (DEPTH, 2, LRU_W), jnp.float32, 0.9, 0.999)
    return {
        'x_prompt': jax.random.normal(ks[0], (BATCH, SEQ, D_MODEL), jnp.float32),
        'x_sample': jax.random.normal(ks[1], (DEC_BATCH, DEC_SEQ, D_MODEL), jnp.float32),
        'cache_ckv': jax.random.normal(ks[2], (DEC_BATCH, DEPTH, PAST_LEN, KV_LORA), jnp.float32),
        'cache_krope': jax.random.normal(ks[3], (DEC_BATCH, DEPTH, PAST_LEN, QK_ROPE), jnp.float32),
        'state_lru': 0.5 * jax.random.normal(ks[4], (DEC_BATCH, DEPTH, 2, LRU_W), jnp.float32),
        'c': jax.random.normal(ks[5], (DEC_BATCH, D_MODEL), jnp.float32),
        'c_ctx': jax.random.normal(ks[6], (D_MODEL,), jnp.float32),
        'norm1_g': _g(ks[7], (DEPTH, D_MODEL)),
        'ada_w': _w(ks[8], (DEPTH, D_MODEL, 6 * D_MODEL), D_MODEL, 0.5),
        'ada_b': _b(ks[9], (DEPTH, 6 * D_MODEL)),
        'w_in': _w(ks[10], (DEPTH, D_MODEL, IN_W), D_MODEL),
        'conv_w': _w(ks[11], (DEPTH, CONV_K, CONV_W), CONV_K),
        'conv_b': _b(ks[12], (DEPTH, CONV_W)),
        'lru_conv_w': _w(ks[13], (DEPTH, LRU_CONV_K, LRU_W), LRU_CONV_K),
        'lru_conv_b': _b(ks[14], (DEPTH, LRU_W)),
        'lru_wa': _w(ks[15], (DEPTH, 2, LRU_BLOCKS, LRU_BLK, LRU_BLK), LRU_BLK),
        'lru_ba': _b(ks[16], (DEPTH, 2, LRU_W)),
        'lru_wi': _w(ks[17], (DEPTH, 2, LRU_BLOCKS, LRU_BLK, LRU_BLK), LRU_BLK),
        'lru_bi': _b(ks[18], (DEPTH, 2, LRU_W)),
        'lru_lambda': jnp.log(a_init) - jnp.log1p(-a_init),
        'mla_qnorm_g': _g(ks[20], (DEPTH, Q_LORA)),
        'mla_wq_up': _w(ks[21], (DEPTH, Q_LORA, MLA_HEADS * QK_DIM), Q_LORA),
        'mla_kvnorm_g': _g(ks[22], (DEPTH, KV_LORA)),
        'mla_wkv_up': _w(ks[23], (DEPTH, KV_LORA, MLA_HEADS * (QK_NOPE + V_DIM)), KV_LORA),
        'q_norm_g': _g(ks[24], (DEPTH, QK_DIM)),
        'k_norm_g': _g(ks[25], (DEPTH, QK_DIM)),
        'gnorm_conv': _g(ks[26], (DEPTH, CONV_W)),
        'gnorm_lru': _g(ks[27], (DEPTH, LRU_W)),
        'gnorm_mla': _g(ks[28], (DEPTH, MLA_W)),
        'w_out': _w(ks[29], (DEPTH, MIX_W, D_MODEL), MIX_W),
        'norm2_g': _g(ks[30], (DEPTH, D_MODEL)),
        'w_gate': _w(ks[31], (DEPTH, D_MODEL, FF), D_MODEL),
        'w_up': _w(ks[32], (DEPTH, D_MODEL, FF), D_MODEL),
        'w_down': _w(ks[33], (DEPTH, FF, D_MODEL), FF),
    }


def reference(x_prompt, x_sample, cache_ckv, cache_krope, state_lru, c, c_ctx,
              norm1_g, ada_w, ada_b, w_in, conv_w, conv_b, lru_conv_w, lru_conv_b,
              lru_wa, lru_ba, lru_wi, lru_bi, lru_lambda, mla_qnorm_g, mla_wq_up,
              mla_kvnorm_g, mla_wkv_up, q_norm_g, k_norm_g, gnorm_conv, gnorm_lru,
              gnorm_mla, w_out, norm2_g, w_gate, w_up, w_down):
    rope = axial_rope_tables(x_sample.shape[1])
    ctx_cond = c_ctx[None, :]
    h0_zero = jnp.zeros((x_prompt.shape[0], LRU_W), x_prompt.dtype)
    xp = x_prompt
    xs = x_sample
    ckv_list, kr_list, lru_list = [], [], []
    for l in range(DEPTH):
        lp = {
            'norm1_g': norm1_g[l], 'ada_w': ada_w[l], 'ada_b': ada_b[l], 'w_in': w_in[l],
            'conv_w': conv_w[l], 'conv_b': conv_b[l], 'lru_conv_w': lru_conv_w[l],
            'lru_conv_b': lru_conv_b[l], 'lru_wa': lru_wa[l], 'lru_ba': lru_ba[l],
            'lru_wi': lru_wi[l], 'lru_bi': lru_bi[l], 'lru_lambda': lru_lambda[l],
            'mla_qnorm_g': mla_qnorm_g[l], 'mla_wq_up': mla_wq_up[l],
            'mla_kvnorm_g': mla_kvnorm_g[l], 'mla_wkv_up': mla_wkv_up[l],
            'q_norm_g': q_norm_g[l], 'k_norm_g': k_norm_g[l], 'gnorm_conv': gnorm_conv[l],
            'gnorm_lru': gnorm_lru[l], 'gnorm_mla': gnorm_mla[l], 'w_out': w_out[l],
            'norm2_g': norm2_g[l], 'w_gate': w_gate[l], 'w_up': w_up[l], 'w_down': w_down[l],
        }
        xp, ckv, kr, hf, hb = trunk_layer(xp, ctx_cond, lp, None, None, None, h0_zero, h0_zero)
        ckv_list.append(ckv)
        kr_list.append(kr)
        lru_list.append(jnp.stack([hf, hb], axis=1))
        xs, _, _, _, _ = trunk_layer(xs, c, lp, rope, cache_ckv[:, l], cache_krope[:, l],
                                     state_lru[:, l, 0], state_lru[:, l, 1])
    new_cache_ckv = jnp.stack(ckv_list, axis=1)
    new_cache_krope = jnp.stack(kr_list, axis=1)
    new_state_lru = jnp.stack(lru_list, axis=1)
    return (xp, xs, new_cache_ckv, new_cache_krope, new_state_lru)
```

```cpp
#include <hip/hip_runtime.h>
#include <hip/hip_cooperative_groups.h>
#include <cstdio>
namespace cg = cooperative_groups;

namespace pg8 {
#define PG8_LAS __attribute__((address_space(3)))
typedef unsigned short bf16_t;
typedef short bf16x8 __attribute__((ext_vector_type(8)));
typedef float f32x4 __attribute__((ext_vector_type(4)));
typedef unsigned u32x4 __attribute__((ext_vector_type(4)));
constexpr int BM = 256, BK = 64, HALF = 128, HTB = HALF * BK * 2  , STAGE_BYTES = 8 * HTB, NXCD = 8, WGM = 8;

__host__ __device__ __forceinline__ int lds_byte(int r, int c) { const int st = (r >> 4) * 2 + (c >> 5), rr = r & 15, cc = c & 31, ob = rr * 64 + cc * 2; return st * 1024 + (ob ^ (((ob >> 9) & 1) << 5)); }
__host__ __device__ __forceinline__ void stage_rc(int b, int& R, int& C) { const int st = b / 1024, sb = b % 1024, swz = sb ^ (((sb >> 9) & 1) << 5); R = (st >> 1) * 16 + swz / 64; C = (st & 1) * 32 + (swz % 64) / 2; }
__host__ __device__ __forceinline__ int perm32(int rho) { const int n = rho >> 4, i = rho & 15; return 8 * (i >> 2) + 4 * n + (i & 3); }

struct Unit { int pm, pn; };
struct Gemm { const bf16_t* A; const bf16_t* Bt; int M, N, K; };

struct StaticOrder {
    int nM, nN, nwg, G, c;
    __host__ __device__ void init(int M, int N, int G_, int c_) { nM = M / BM; nN = N / BM; nwg = nM * nN; G = G_; c = c_; }
    __host__ __device__ bool next(int i, Unit& u) const {
        const long L = (long)i * G + c; if (L >= nwg) return false;
        int wgid = (int)L; { const int q = nwg / NXCD, r = nwg % NXCD, xcd = wgid % NXCD, off = wgid / NXCD; wgid = (xcd < r ? xcd * (q + 1) : r * (q + 1) + (xcd - r) * q) + off; }
        const int nig = WGM * nN, gid = wgid / nig, fm = gid * WGM, gsz = (nM - fm) < WGM ? (nM - fm) : WGM;
        u.pm = fm + ((wgid % nig) % gsz); u.pn = (wgid % nig) / gsz; return true;
    }
    __device__ __forceinline__ void a_ready(const Unit&) const {}
    __device__ __forceinline__ void done(const Unit&) const {}
};
__device__ __forceinline__ unsigned cvt_pk_bf16(float lo, float hi) { unsigned r; asm volatile("v_cvt_pk_bf16_f32 %0, %1, %2" : "=v"(r) : "v"(lo), "v"(hi)); return r; }
typedef float f32x2 __attribute__((ext_vector_type(2)));
__device__ __forceinline__ f32x2 gelu_pk(f32x2 v) {
    const f32x2 av = __builtin_elementwise_abs(v), d = av * 0.2316418882f + 1.0f;
    f32x2 t; t.x = __builtin_amdgcn_rcpf(d.x); t.y = __builtin_amdgcn_rcpf(d.y);
    f32x2 q = t * 0.5307027145f + (-0.7265760135f); q = q * t + 0.7107068705f; q = q * t + (-0.142248368f); q = q * t + 0.127414796f; q = q * t;
    const f32x2 s = (v * v) * (-0.72134752044f);
    f32x2 e; e.x = __builtin_amdgcn_exp2f(s.x); e.y = __builtin_amdgcn_exp2f(s.y);
    const f32x2 m = v * (q * e), r = v - m;
    f32x2 o; o.x = v.x < 0.f ? m.x : r.x; o.y = v.y < 0.f ? m.y : r.y; return o;
}
template <int ACT  > struct EpiBf16 {
    static constexpr bool PERM = true, AFTER_DRAIN = false;
    bf16_t* O; int ldc; const float* bias; int split_cols; size_t split_stride;
    __device__ __forceinline__ void operator()(const f32x4 (&acc)[2][2][4][2], const Unit& u, int wr, int wc, int fr, int fq) const {
        const int row0 = u.pm * BM + wr * 64 + fr; int colt = u.pn * BM; bf16_t* base = O;
        if (split_cols) { const int t = colt / split_cols; base += (size_t)t * split_stride; colt -= t * split_cols; }
        const int col0 = colt + wc * 32 + 8 * fq, bcol0 = u.pn * BM + wc * 32 + 8 * fq;
        f32x4 bv[2][2];
#pragma unroll
        for (int bj = 0; bj < 2; ++bj)
#pragma unroll
            for (int n = 0; n < 2; ++n) bv[bj][n] = bias ? *(const f32x4*)(bias + bcol0 + bj * HALF + 4 * n) : (f32x4){0.f, 0.f, 0.f, 0.f};
#pragma unroll
        for (int ai = 0; ai < 2; ++ai)
#pragma unroll
            for (int m = 0; m < 4; ++m) { bf16_t* rowp = base + (size_t)(row0 + ai * HALF + m * 16) * ldc + col0;
#pragma unroll
                for (int bj = 0; bj < 2; ++bj) { f32x4 v0 = acc[ai][bj][m][0] + bv[bj][0], v1 = acc[ai][bj][m][1] + bv[bj][1];
                    if (ACT == 1) { f32x2 a = gelu_pk((f32x2){v0[0], v0[1]}), b = gelu_pk((f32x2){v0[2], v0[3]}), c = gelu_pk((f32x2){v1[0], v1[1]}), d = gelu_pk((f32x2){v1[2], v1[3]});
                        v0 = (f32x4){a.x, a.y, b.x, b.y}; v1 = (f32x4){c.x, c.y, d.x, d.y}; }
                    if (ACT == 2) {
#pragma unroll
                        for (int j = 0; j < 4; ++j) { v0[j] = 0.5f * v0[j] * (1.0f + erff(v0[j] * 0.70710678f)); v1[j] = 0.5f * v1[j] * (1.0f + erff(v1[j] * 0.70710678f)); } }
                    u32x4 w; w.x = cvt_pk_bf16(v0[0], v0[1]); w.y = cvt_pk_bf16(v0[2], v0[3]); w.z = cvt_pk_bf16(v1[0], v1[1]); w.w = cvt_pk_bf16(v1[2], v1[3]);
                    *(u32x4*)(rowp + bj * HALF) = w; } }
    }
};
template <class Epi, class Sched, bool STAMP = false>
__device__ __forceinline__ void gemm_phase(PG8_LAS unsigned char* lds, const Gemm g, const Sched& S, const Epi& E, unsigned long long* stamps, int tid_in) {
    const int tid = tid_in, wid = __builtin_amdgcn_readfirstlane(tid >> 6), lane = tid & 63, wr = wid >> 2, wc = wid & 3, fr = lane & 15, fq = lane >> 4;
    const int K = g.K, nt = K / BK;
    int ts_lo = 0, ts_hi = 0, nts = 0; const unsigned long long rt_entry = STAMP ? (unsigned long long)wall_clock64() : 0ull;
#define PG8_STAMP() do { if (STAMP && wid == 0 && nts < 64) { const unsigned long long _c = (unsigned long long)clock64(); \
        ts_lo = (lane == nts) ? (int)(unsigned)_c : ts_lo; ts_hi = (lane == nts) ? (int)(unsigned)(_c >> 32) : ts_hi; ++nts; } } while (0)
    PG8_STAMP();
    unsigned voffA[2], voffB[2];
#pragma unroll
    for (int i = 0; i < 2; ++i) { int R, C; stage_rc(tid * 16 + i * 8192, R, C); const int Rb = Epi::PERM ? ((R & ~31) + perm32(R & 31)) : R;
        voffA[i] = (unsigned)(R * K + C) * 2u; voffB[i] = (unsigned)(Rb * K + C) * 2u; }
    const size_t kstep = (size_t)(BK * 2);
    const size_t hstep = (size_t)HALF * K * 2;
    const size_t tstep = 2 * hstep;
    const unsigned ldsw = (unsigned)wid * 1024u;
    const int aoff = lds_byte(wr * 64 + fr, fq * 8), boff = lds_byte(wc * 32 + fr, fq * 8);
#define PG8_SA(b, h) (((b) * 2 + (h)) * HTB)
#define PG8_SB(b, h) ((4 + (b) * 2 + (h)) * HTB)
#define PG8_STAGE(bufoff, gbase, voff) do { _Pragma("unroll") for (int _i = 0; _i < 2; ++_i) \
        __builtin_amdgcn_global_load_lds((const unsigned*)((const char*)(gbase) + (voff)[_i]), (PG8_LAS unsigned*)(lds + (bufoff) + ldsw + _i * 8192), 16, 0, 0); } while (0)
#define PG8_LDA(dst, b, h) do { _Pragma("unroll") for (int m = 0; m < 4; ++m) _Pragma("unroll") for (int k = 0; k < 2; ++k) dst[m][k] = *(const PG8_LAS bf16x8*)(lds + PG8_SA(b, h) + aoff + m * 2048 + k * 1024); } while (0)
#define PG8_LDB(dst, b, h) do { _Pragma("unroll") for (int n = 0; n < 2; ++n) _Pragma("unroll") for (int k = 0; k < 2; ++k) dst[n][k] = *(const PG8_LAS bf16x8*)(lds + PG8_SB(b, h) + boff + n * 2048 + k * 1024); } while (0)
#define PG8_MMA(ai, bj, At, Bt) do { __builtin_amdgcn_s_setprio(1); _Pragma("unroll") for (int m = 0; m < 4; ++m) _Pragma("unroll") for (int n = 0; n < 2; ++n) _Pragma("unroll") for (int k = 0; k < 2; ++k) \
        acc[ai][bj][m][n] = __builtin_amdgcn_mfma_f32_16x16x32_bf16(Bt[n][k], At[m][k], acc[ai][bj][m][n], 0, 0, 0); __builtin_amdgcn_s_setprio(0); } while (0)
#define PG8_WAIT_V(n) asm volatile("s_waitcnt vmcnt(" #n ")" ::: "memory")
#define PG8_WAIT_L(n) asm volatile("s_waitcnt lgkmcnt(" #n ")" ::: "memory")
#define PG8_BAR __builtin_amdgcn_s_barrier()
#define PG8_SCHED __builtin_amdgcn_sched_barrier(0)
    Unit cur, nxt; int ui = 0;
    if (!S.next(0, cur)) return;
    f32x4 acc[2][2][4][2];
#pragma unroll
    for (int a = 0; a < 2; ++a)
#pragma unroll
        for (int b = 0; b < 2; ++b)
#pragma unroll
            for (int m = 0; m < 4; ++m)
#pragma unroll
                for (int n = 0; n < 2; ++n) acc[a][b][m][n] = (f32x4){0.f, 0.f, 0.f, 0.f};
    bf16x8 At[4][2], B0[2][2], B1[2][2];
    const char* cA = (const char*)g.A + (size_t)cur.pm * tstep; const char* cB = (const char*)g.Bt + (size_t)cur.pn * tstep;
    S.a_ready(cur);
    PG8_STAGE(PG8_SB(0, 0), cB, voffB); PG8_STAGE(PG8_SA(0, 0), cA, voffA); PG8_STAGE(PG8_SB(0, 1), cB + hstep, voffB); PG8_STAGE(PG8_SA(0, 1), cA + hstep, voffA);
    if (wr == 1) PG8_BAR;
    PG8_WAIT_V(4); PG8_BAR;
    PG8_STAGE(PG8_SB(1, 0), cB + kstep, voffB); PG8_STAGE(PG8_SA(1, 0), cA + kstep, voffA); PG8_STAGE(PG8_SB(1, 1), cB + hstep + kstep, voffB);
    PG8_WAIT_V(6); PG8_BAR;
    PG8_STAMP();
    for (;;) {
        const bool has_next = S.next(ui + 1, nxt);
        const char* nA = has_next ? (const char*)g.A + (size_t)nxt.pm * tstep : cA; const char* nB = has_next ? (const char*)g.Bt + (size_t)nxt.pn * tstep : cB;
        for (int t = 0; t < nt; t += 2) {
            const bool last = (t == nt - 2);
            const char* a1 = cA + (size_t)(t + 1) * kstep;
            const char* a2 = last ? nA : cA + (size_t)(t + 2) * kstep; const char* b2 = last ? nB : cB + (size_t)(t + 2) * kstep;
            const char* a3 = a2 + kstep; const char* b3 = b2 + kstep;
            if (last && has_next) S.a_ready(nxt);
            PG8_LDB(B0, 0, 0); PG8_SCHED; PG8_LDA(At, 0, 0); PG8_STAGE(PG8_SA(1, 1), a1 + hstep, voffA);
            PG8_WAIT_L(8); PG8_BAR; PG8_WAIT_L(0); PG8_MMA(0, 0, At, B0); PG8_BAR; PG8_SCHED;
            PG8_LDB(B1, 0, 1); PG8_STAGE(PG8_SB(0, 0), b2, voffB);
            PG8_BAR; PG8_WAIT_L(0); PG8_MMA(0, 1, At, B1); PG8_BAR;
            PG8_LDA(At, 0, 1); PG8_STAGE(PG8_SA(0, 0), a2, voffA);
            PG8_BAR; PG8_WAIT_L(0); PG8_MMA(1, 0, At, B0); PG8_BAR; PG8_SCHED;
            PG8_STAGE(PG8_SB(0, 1), b2 + hstep, voffB);
            PG8_WAIT_V(6); PG8_BAR; PG8_MMA(1, 1, At, B1); PG8_BAR;
            PG8_LDB(B0, 1, 0); PG8_SCHED; PG8_LDA(At, 1, 0); PG8_STAGE(PG8_SA(0, 1), a2 + hstep, voffA);
            PG8_WAIT_L(8); PG8_BAR; PG8_WAIT_L(0); PG8_MMA(0, 0, At, B0); PG8_BAR; PG8_SCHED;
            PG8_LDB(B1, 1, 1); PG8_STAGE(PG8_SB(1, 0), b3, voffB);
            PG8_BAR; PG8_WAIT_L(0); PG8_MMA(0, 1, At, B1); PG8_BAR;
            PG8_LDA(At, 1, 1); PG8_STAGE(PG8_SA(1, 0), a3, voffA);
            PG8_BAR; PG8_WAIT_L(0); PG8_MMA(1, 0, At, B0); PG8_BAR; PG8_SCHED;
            PG8_STAGE(PG8_SB(1, 1), b3 + hstep, voffB);
            PG8_WAIT_V(6); PG8_BAR; PG8_MMA(1, 1, At, B1); PG8_BAR;
        }
        PG8_STAMP();
        if constexpr (!Epi::AFTER_DRAIN) { E(acc, cur, wr, wc, fr, fq); S.done(cur); }
        PG8_STAMP();
        if (!has_next) break;
#pragma unroll
        for (int a = 0; a < 2; ++a)
#pragma unroll
            for (int b = 0; b < 2; ++b)
#pragma unroll
                for (int m = 0; m < 4; ++m)
#pragma unroll
                    for (int n = 0; n < 2; ++n) acc[a][b][m][n] = (f32x4){0.f, 0.f, 0.f, 0.f};
        cur = nxt; cA = nA; cB = nB; ++ui;
    }
    PG8_WAIT_V(0);
    if (wr == 0) PG8_BAR;
    PG8_BAR;
    if constexpr (Epi::AFTER_DRAIN) { E.fused(acc, cur, wr, wc, fr, fq, lds, wid, lane); S.done(cur); }
    PG8_STAMP();
    if (STAMP && wid == 0) { stamps[lane] = lane < nts ? (((unsigned long long)(unsigned)ts_hi << 32) | (unsigned)ts_lo) : 0ull;
        if (lane == 62) stamps[62] = rt_entry; if (lane == 63) stamps[63] = (unsigned long long)wall_clock64(); }
#undef PG8_STAMP
#undef PG8_SA
#undef PG8_SB
#undef PG8_STAGE
#undef PG8_LDA
#undef PG8_LDB
#undef PG8_MMA
#undef PG8_WAIT_V
#undef PG8_WAIT_L
#undef PG8_BAR
#undef PG8_SCHED
}
}

#define DI __device__ __forceinline__
#define LAS __attribute__((address_space(3)))
typedef unsigned short bf16_t;
typedef short bf16x8 __attribute__((ext_vector_type(8)));
typedef short s16x4 __attribute__((ext_vector_type(4)));
typedef float f32x4 __attribute__((ext_vector_type(4)));
typedef float f32x16 __attribute__((ext_vector_type(16)));
typedef unsigned u32x4 __attribute__((ext_vector_type(4)));
typedef unsigned u32x2 __attribute__((ext_vector_type(2)));

constexpr int NT = 512;
constexpr int D = 1024, TC = 8192, TLAT = 4096, T = TC + TLAT, TKV = T + 1024;
constexpr int INW = 1696, INWP = 1792, FF = 2816;
constexpr int LDS_BYTES = 131072;
constexpr float EPS = 1e-6f;
constexpr float QSCALE = 0.10206207261596577f * 1.4426950408889634f;

constexpr size_t WS_WT_IN = 0;
constexpr size_t WS_WT_QUP = WS_WT_IN + (size_t)INWP * 1024 * 2;
constexpr size_t WS_WT_KVUP = WS_WT_QUP + (size_t)768 * 256 * 2;
constexpr size_t WS_WT_OUT = WS_WT_KVUP + (size_t)1024 * 256 * 2;
constexpr size_t WS_WT_GU = WS_WT_OUT + (size_t)1024 * 1024 * 2;
constexpr size_t WS_WT_DN = WS_WT_GU + (size_t)2 * FF * 1024 * 2;
constexpr size_t WS_MOD = WS_WT_DN + (size_t)1024 * FF * 2;
constexpr size_t WS_R1 = WS_MOD + (size_t)2 * 5 * 6144 * 4;
constexpr size_t WS_XC = WS_R1 + (size_t)T * INWP * 2;
constexpr size_t WS_R2 = WS_R1 + (size_t)T * FF * 2;
constexpr size_t WS_R3 = WS_R2 + (size_t)T * 1024 * 2;
constexpr size_t WS_KVRAW = WS_R3 + (size_t)T * 768 * 2;
constexpr size_t WS_R4 = WS_KVRAW + (size_t)TKV * 1024 * 2;
constexpr size_t WS_CKV = WS_R4 + (size_t)T * 256 * 2;
constexpr size_t WS_K = WS_R4 + (size_t)T * 768 * 2;
constexpr size_t WS_VT = WS_K + (size_t)TKV * 768 * 2;
constexpr size_t WS_HF = WS_VT + (size_t)TKV * 512 * 2;
constexpr size_t WS_END = WS_HF + (size_t)2 * T * 256 * 4;
static_assert(WS_END <= (size_t)256 * 1024 * 1024, "workspace too large");
static_assert((size_t)T * 256 * 2 + (size_t)TKV * 256 * 2 <= (size_t)T * 768 * 2, "QLAT+CKV must fit in Q region");

constexpr size_t OUT_CKV = (size_t)T * 1024, OUT_KR = OUT_CKV + (size_t)32 * 2 * 256 * 128, OUT_ST = OUT_KR + (size_t)32 * 2 * 256 * 32;

struct Params { const float* in[34]; float* out; unsigned char* ws; int ph_lo, ph_hi; };
enum { I_XP = 0, I_XS, I_CCKV, I_CKR, I_STATE, I_C, I_CCTX, I_N1G, I_ADAW, I_ADAB, I_WIN, I_CONVW, I_CONVB, I_LCW, I_LCB, I_LWA, I_LBA, I_LWI, I_LBI, I_LAM,
       I_QNG, I_WQUP, I_KVNG, I_WKVUP, I_QHG, I_KHG, I_GNC, I_GNL, I_GNM, I_WOUT, I_N2G, I_WG, I_WU, I_WD };

DI unsigned pack2(float lo, float hi) {
    typedef __bf16 bf2 __attribute__((ext_vector_type(2))); typedef float f2 __attribute__((ext_vector_type(2)));
    f2 v = {lo, hi}; bf2 b = __builtin_convertvector(v, bf2); return __builtin_bit_cast(unsigned, b);
}
DI float bf2f(unsigned short b) { return __uint_as_float(((unsigned)b) << 16); }
DI float bflo(unsigned w) { return __uint_as_float(w << 16); }
DI float bfhi(unsigned w) { return __uint_as_float(w & 0xffff0000u); }
DI float wave_sum(float v) {
#pragma unroll
    for (int o = 32; o >= 1; o >>= 1) v += __shfl_xor(v, o);
    return v;
}
DI float sigmoidf_(float x) { return 1.0f / (1.0f + __expf(-x)); }

DI void phase_mod(const Params& p, LAS unsigned char* lds, int tx) {
    const int tid = tx;
    LAS float* sc = (LAS float*)lds;
    LAS float* red = (LAS float*)(lds + 20480);
    for (int i = tid; i < 5 * 1024; i += NT) { const int ci = i >> 10, k = i & 1023; const float v = (ci == 0) ? p.in[I_CCTX][k] : p.in[I_C][(ci - 1) * 1024 + k]; sc[i] = v / (1.0f + __expf(-v)); }
    __syncthreads();
    float* mod = (float*)(p.ws + WS_MOD);
    const int col = tid & 63, kg = tid >> 6;
    for (int unit = blockIdx.x; unit < 192; unit += gridDim.x) {
        const int l = unit / 96, n0 = (unit % 96) * 64;
        const float* w = p.in[I_ADAW] + (size_t)l * 1024 * 6144 + n0 + col;
        float a0 = 0.f, a1 = 0.f, a2 = 0.f, a3 = 0.f, a4 = 0.f;
#pragma unroll 8
        for (int k = kg * 128; k < kg * 128 + 128; ++k) { const float wv = w[(size_t)k * 6144]; a0 += sc[k] * wv; a1 += sc[1024 + k] * wv; a2 += sc[2048 + k] * wv; a3 += sc[3072 + k] * wv; a4 += sc[4096 + k] * wv; }
        LAS float* r = red + (kg * 64 + col) * 5; r[0] = a0; r[1] = a1; r[2] = a2; r[3] = a3; r[4] = a4;
        __syncthreads();
        if (tid < 320) { const int c = tid >> 6, c2 = tid & 63; float s = 0.f;
#pragma unroll
            for (int g = 0; g < 8; ++g) s += red[(g * 64 + c2) * 5 + c];
            mod[(size_t)(l * 5 + c) * 6144 + n0 + c2] = s + p.in[I_ADAB][l * 6144 + n0 + c2]; }
        __syncthreads();
    }
}

DI void cvt_tile(const float* src, bf16_t* dst, int K, int N, int Kpad, int kt, int nt, int mode, LAS unsigned char* lds, int tx) {
    LAS float* tile = (LAS float*)lds;
    const int tid = tx, cx = tid & 63, ty = tid >> 6;
#pragma unroll
    for (int i = 0; i < 8; ++i) { const int k = kt * 64 + ty + 8 * i, n = nt * 64 + cx; const float v = (k < K && n < N) ? src[(size_t)k * N + n] : 0.f; tile[(ty + 8 * i) * 65 + cx] = v; }
    __syncthreads();
    const int nl = tid >> 3, kc = (tid & 7) * 8, n = nt * 64 + nl;
    u32x4 w;
    w.x = pack2(tile[(kc + 0) * 65 + nl], tile[(kc + 1) * 65 + nl]); w.y = pack2(tile[(kc + 2) * 65 + nl], tile[(kc + 3) * 65 + nl]);
    w.z = pack2(tile[(kc + 4) * 65 + nl], tile[(kc + 5) * 65 + nl]); w.w = pack2(tile[(kc + 6) * 65 + nl], tile[(kc + 7) * 65 + nl]);
    const int R = (mode == 0) ? n : (2 * (n & ~15) + 16 * (mode - 1) + (n & 15));
    *(u32x4*)(dst + (size_t)R * Kpad + kt * 64 + kc) = w;
    __syncthreads();
}
DI void phase_convert(const Params& p, int l, LAS unsigned char* lds, int tx) {
    const int c0 = 16 * 28, c1 = c0 + 4 * 12, c2 = c1 + 4 * 16, c3 = c2 + 16 * 16, c4 = c3 + 16 * 44, c5 = c4 + 16 * 44, c6 = c5 + 44 * 16;
    for (int u = blockIdx.x; u < c6; u += gridDim.x) {
        if (u < c0)      { const int v = u;      cvt_tile(p.in[I_WIN] + (size_t)l * 1024 * INW, (bf16_t*)(p.ws + WS_WT_IN), 1024, INW, 1024, v % 16, v / 16, 0, lds, tx); }
        else if (u < c1) { const int v = u - c0; cvt_tile(p.in[I_WQUP] + (size_t)l * 256 * 768, (bf16_t*)(p.ws + WS_WT_QUP), 256, 768, 256, v % 4, v / 4, 0, lds, tx); }
        else if (u < c2) { const int v = u - c1; cvt_tile(p.in[I_WKVUP] + (size_t)l * 128 * 1024, (bf16_t*)(p.ws + WS_WT_KVUP), 128, 1024, 256, v % 4, v / 4, 0, lds, tx); }
        else if (u < c3) { const int v = u - c2; cvt_tile(p.in[I_WOUT] + (size_t)l * 1024 * 1024, (bf16_t*)(p.ws + WS_WT_OUT), 1024, 1024, 1024, v % 16, v / 16, 0, lds, tx); }
        else if (u < c4) { const int v = u - c3; cvt_tile(p.in[I_WG] + (size_t)l * 1024 * FF, (bf16_t*)(p.ws + WS_WT_GU), 1024, FF, 1024, v % 16, v / 16, 1, lds, tx); }
        else if (u < c5) { const int v = u - c4; cvt_tile(p.in[I_WU] + (size_t)l * 1024 * FF, (bf16_t*)(p.ws + WS_WT_GU), 1024, FF, 1024, v % 16, v / 16, 2, lds, tx); }
        else             { const int v = u - c5; cvt_tile(p.in[I_WD] + (size_t)l * FF * 1024, (bf16_t*)(p.ws + WS_WT_DN), FF, 1024, FF, v % 44, v / 44, 0, lds, tx); }
    }
}

DI void phase_prep(const Params& p, const float* xa, const float* xb, const float* g, const float* modl, int shoff, int scoff, int tx) {
    const int lane = tx & 63, wave = tx >> 6;
    bf16_t* HN = (bf16_t*)(p.ws + WS_R2);
    for (int r = blockIdx.x * 8 + wave; r < T; r += gridDim.x * 8) {
        const float* x = (r < TC) ? xa + (size_t)r * D : xb + (size_t)(r - TC) * D;
        const int ci = (r < TC) ? 0 : 1 + ((r - TC) >> 10);
        f32x4 v[4]; float ss = 0.f;
#pragma unroll
        for (int i = 0; i < 4; ++i) { v[i] = *(const f32x4*)(x + 4 * (lane + 64 * i)); ss += v[i][0] * v[i][0] + v[i][1] * v[i][1] + v[i][2] * v[i][2] + v[i][3] * v[i][3]; }
        ss = wave_sum(ss);
        const float inv = rsqrtf(ss * (1.0f / 1024.0f) + EPS);
#pragma unroll
        for (int i = 0; i < 4; ++i) { const int col = 4 * (lane + 64 * i);
            const f32x4 gv = *(const f32x4*)(g + col), sc = *(const f32x4*)(modl + ci * 6144 + scoff + col), sh = *(const f32x4*)(modl + ci * 6144 + shoff + col);
            const f32x4 y = (v[i] * inv * gv) * (sc + 1.0f) + sh;
            u32x2 w; w.x = pack2(y[0], y[1]); w.y = pack2(y[2], y[3]);
            *(u32x2*)(HN + (size_t)r * D + col) = w; }
    }
}

DI void phase_post_in(const Params& p, int l, int tx) {
    const int lane = tx & 63, wave = tx >> 6;
    const bf16_t* U = (const bf16_t*)(p.ws + WS_R1);
    float* XC = (float*)(p.ws + WS_XC);
    bf16_t* QLAT = (bf16_t*)(p.ws + WS_R4);
    bf16_t* CKV = (bf16_t*)(p.ws + WS_CKV);
    const float* qg = p.in[I_QNG] + l * 256; const float* kvg = p.in[I_KVNG] + l * 128;
    const float* cw = p.in[I_LCW] + l * 4 * 256; const float* cb = p.in[I_LCB] + l * 256;
    for (int r = blockIdx.x * 8 + wave; r < T + 1024; r += gridDim.x * 8) {
        if (r < T) {
            const bf16_t* u = U + (size_t)r * INWP;
            {
                const u32x2 w = *(const u32x2*)(u + 1280 + 4 * lane);
                const float a = bflo(w.x), b = bfhi(w.x), c = bflo(w.y), d = bfhi(w.y);
                const float ss = wave_sum(a * a + b * b + c * c + d * d);
                const float inv = rsqrtf(ss * (1.0f / 256.0f) + EPS);
                const f32x4 g = *(const f32x4*)(qg + 4 * lane);
                u32x2 o; o.x = pack2(a * inv * g[0], b * inv * g[1]); o.y = pack2(c * inv * g[2], d * inv * g[3]);
                *(u32x2*)(QLAT + (size_t)r * 256 + 4 * lane) = o;
            }
            {
                const unsigned w = *(const unsigned*)(u + 1536 + 2 * lane);
                const float a = bflo(w), b = bfhi(w);
                const float ss = wave_sum(a * a + b * b);
                const float inv = rsqrtf(ss * (1.0f / 128.0f) + EPS);
                const float y0 = a * inv * kvg[2 * lane], y1 = b * inv * kvg[2 * lane + 1];
                *(unsigned*)(CKV + (size_t)r * 256 + 2 * lane) = pack2(y0, y1);
                *(unsigned*)(CKV + (size_t)r * 256 + 128 + 2 * lane) = 0u;
                if (r < TC) { const int b_ = r >> 8, s = r & 255; float* o = p.out + OUT_CKV + ((size_t)(b_ * 2 + l) * 256 + s) * 128 + 2 * lane; o[0] = y0; o[1] = y1; }
            }
            if (r < TC && lane < 32) { const int b_ = r >> 8, s = r & 255; p.out[OUT_KR + ((size_t)(b_ * 2 + l) * 256 + s) * 32 + lane] = bf2f(u[1664 + lane]); }
            {
                const int s = (r < TC) ? (r & 255) : ((r - TC) & 1023), S = (r < TC) ? 256 : 1024;
                f32x4 acc = *(const f32x4*)(cb + 4 * lane);
#pragma unroll
                for (int k = 0; k < 4; ++k) { const int sk = s + k - 2;
                    if (sk >= 0 && sk < S) { const u32x2 w = *(const u32x2*)(U + (size_t)(r + k - 2) * INWP + 768 + 4 * lane); const f32x4 wv = *(const f32x4*)(cw + k * 256 + 4 * lane);
                        acc[0] += wv[0] * bflo(w.x); acc[1] += wv[1] * bfhi(w.x); acc[2] += wv[2] * bflo(w.y); acc[3] += wv[3] * bfhi(w.y); } }
                *(f32x4*)(XC + (size_t)r * 256 + 4 * lane) = acc;
            }
        } else {
            const int rc = r - T, b_ = rc >> 8, s = rc & 255;
            const float* src = p.in[I_CCKV] + ((size_t)(b_ * 2 + l) * 256 + s) * 128 + 2 * lane;
            *(unsigned*)(CKV + (size_t)r * 256 + 2 * lane) = pack2(src[0], src[1]);
            *(unsigned*)(CKV + (size_t)r * 256 + 128 + 2 * lane) = 0u;
        }
    }
}

DI void scan_unit(const Params& p, int l, int sigma, int dir, int n, LAS unsigned char* lds, int tx) {
    const int tid = tx, j = tid & 63, chunk = __builtin_amdgcn_readfirstlane(tid >> 6);
    const int S = (sigma < 32) ? 256 : 1024, row0 = (sigma < 32) ? sigma * 256 : TC + (sigma - 32) * 1024, Lc = S >> 3;
    const int c = n * 64 + j;
    const float* XC = (const float*)(p.ws + WS_XC);
    float* Hb = (float*)(p.ws + WS_HF) + (size_t)dir * T * 256;
    float* Pb = (float*)(p.ws + WS_R2) + (size_t)dir * T * 256;
    const float* wap = p.in[I_LWA] + ((size_t)((l * 2 + dir) * 4 + n) * 64) * 64 + j;
    const float* wip = p.in[I_LWI] + ((size_t)((l * 2 + dir) * 4 + n) * 64) * 64 + j;
    float wa[64], wi[64];
#pragma unroll
    for (int k = 0; k < 64; ++k) { wa[k] = wap[k * 64]; wi[k] = wip[k * 64]; }
    const float ba = p.in[I_LBA][(l * 2 + dir) * 256 + c], bi = p.in[I_LBI][(l * 2 + dir) * 256 + c];
    const float lam = p.in[I_LAM][(l * 2 + dir) * 256 + c];
    const float sp = log1pf(__expf(-lam));
    const float h0 = (sigma < 32) ? 0.f : p.in[I_STATE][((size_t)((sigma - 32) * 2 + l) * 2 + dir) * 256 + c];
    float hl = 0.f, P = 1.f;
    const int tau0 = chunk * Lc;
    for (int i = 0; i < Lc; ++i) {
        const int tau = tau0 + i, t = dir ? (S - 1 - tau) : tau, r = row0 + t;
        const float* xr = XC + (size_t)r * 256 + n * 64;
        float za = ba, zi = bi;
#pragma unroll
        for (int k4 = 0; k4 < 16; ++k4) { const f32x4 xv = *(const f32x4*)(xr + 4 * k4);
            za += xv[0] * wa[4 * k4] + xv[1] * wa[4 * k4 + 1] + xv[2] * wa[4 * k4 + 2] + xv[3] * wa[4 * k4 + 3];
            zi += xv[0] * wi[4 * k4] + xv[1] * wi[4 * k4 + 1] + xv[2] * wi[4 * k4 + 2] + xv[3] * wi[4 * k4 + 3]; }
        const float xj = xr[j];
        const float rr = sigmoidf_(za), ii = sigmoidf_(zi);
        const float la = -8.0f * rr * sp;
        const float a = __expf(la);
        const float bt = sqrtf(-expm1f(2.0f * la)) * (ii * xj);
        hl = a * hl + bt; P *= a;
        Hb[(size_t)r * 256 + c] = hl; Pb[(size_t)r * 256 + c] = P;
    }
    LAS float* sP = (LAS float*)lds; LAS float* sH = sP + 512;
    sP[chunk * 64 + j] = P; sH[chunk * 64 + j] = hl;
    __syncthreads();
    float hin = h0;
    for (int cc = 0; cc < chunk; ++cc) hin = sP[cc * 64 + j] * hin + sH[cc * 64 + j];
    float h = 0.f;
    for (int i = 0; i < Lc; ++i) {
        const int tau = tau0 + i, t = dir ? (S - 1 - tau) : tau, r = row0 + t;
        h = Hb[(size_t)r * 256 + c] + Pb[(size_t)r * 256 + c] * hin;
        Hb[(size_t)r * 256 + c] = h;
    }
    if (chunk == 7 && sigma < 32) p.out[OUT_ST + ((size_t)(sigma * 2 + l) * 2 + dir) * 256 + c] = h;
    __syncthreads();
}
DI void phase_scan(const Params& p, int l, LAS unsigned char* lds, int tx) {
    for (int u = blockIdx.x; u < 288; u += gridDim.x) {
        int sigma, rest;
        if (u < 32) { sigma = 32 + (u >> 3); rest = u & 7; } else { sigma = (u - 32) >> 3; rest = (u - 32) & 7; }
        scan_unit(p, l, sigma, rest >> 2, rest & 3, lds, tx);
    }
}

DI void seq_of_row(int r, int& base, int& key, int& Sk) {
    if (r < TC) { base = (r >> 8) * 256; key = r & 255; Sk = 256; }
    else if (r < T) { const int b = (r - TC) >> 10; base = TC + b * 1280; key = (r - TC) & 1023; Sk = 1280; }
    else { const int b = (r - T) >> 8; base = TC + b * 1280; key = 1024 + ((r - T) & 255); Sk = 1280; }
}
DI void phase_qk_finalize(const Params& p, int l, LAS unsigned char* lds, int tx) {
    const int tid = tx, lane = tid & 63, wave = tid >> 6, h = lane >> 3, j = lane & 7;
    const bf16_t* U = (const bf16_t*)(p.ws + WS_R1);
    const bf16_t* QRAW = (const bf16_t*)(p.ws + WS_R3);
    const bf16_t* KVRAW = (const bf16_t*)(p.ws + WS_KVRAW);
    bf16_t* Q = (bf16_t*)(p.ws + WS_R4);
    bf16_t* K = (bf16_t*)(p.ws + WS_K);
    bf16_t* VT = (bf16_t*)(p.ws + WS_VT);
    const float* qhg = p.in[I_QHG] + l * 96; const float* khg = p.in[I_KHG] + l * 96;
    LAS bf16_t* Vs = (LAS bf16_t*)lds;
    float qg[12], kg[12];
#pragma unroll
    for (int i = 0; i < 12; ++i) { qg[i] = qhg[j + 8 * i]; kg[i] = khg[j + 8 * i]; }
    const float invf = __builtin_amdgcn_exp2f(-1.6609640474436813f * (float)j);
    for (int unit = blockIdx.x; unit < TKV / 64; unit += gridDim.x) {
        for (int rr = 0; rr < 8; ++rr) {
            const int r = unit * 64 + wave * 8 + rr;
            int base, key, Sk; seq_of_row(r, base, key, Sk);
            const bool rope = (r >= TC && r < T);
            float c0 = 1.f, s0 = 0.f, c1 = 1.f, s1 = 0.f;
            if (rope) { const int s = (r - TC) & 1023; const float a0 = (float)(s >> 6) * invf, a1 = (float)(s & 63) * invf; c0 = __cosf(a0); s0 = __sinf(a0); c1 = __cosf(a1); s1 = __sinf(a1); }
            if (r < T) {
                float v[12]; float ss = 0.f;
#pragma unroll
                for (int i = 0; i < 12; ++i) { v[i] = bf2f(QRAW[(size_t)r * 768 + h * 96 + j + 8 * i]); ss += v[i] * v[i]; }
                ss += __shfl_xor(ss, 1); ss += __shfl_xor(ss, 2); ss += __shfl_xor(ss, 4);
                const float inv = rsqrtf(ss * (1.0f / 96.0f) + EPS);
#pragma unroll
                for (int i = 0; i < 12; ++i) v[i] = v[i] * inv * qg[i];
                if (rope) { const float x1 = v[8], x2 = v[9], x3 = v[10], x4 = v[11];
                    v[8] = x1 * c0 - x2 * s0; v[9] = x2 * c0 + x1 * s0; v[10] = x3 * c1 - x4 * s1; v[11] = x4 * c1 + x3 * s1; }
#pragma unroll
                for (int i = 0; i < 12; ++i) Q[((size_t)r * 8 + h) * 96 + j + 8 * i] = (bf16_t)(pack2(v[i] * QSCALE, 0.f) & 0xffffu);
            }
            {
                float v[12]; float ss = 0.f;
#pragma unroll
                for (int i = 0; i < 8; ++i) v[i] = bf2f(KVRAW[(size_t)r * 1024 + h * 128 + j + 8 * i]);
                if (r < T) {
#pragma unroll
                    for (int i = 0; i < 4; ++i) v[8 + i] = bf2f(U[(size_t)r * INWP + 1664 + j + 8 * i]);
                } else { const int rc = r - T, b_ = rc >> 8, s = rc & 255;
#pragma unroll
                    for (int i = 0; i < 4; ++i) v[8 + i] = p.in[I_CKR][((size_t)(b_ * 2 + l) * 256 + s) * 32 + j + 8 * i]; }
#pragma unroll
                for (int i = 0; i < 12; ++i) ss += v[i] * v[i];
                ss += __shfl_xor(ss, 1); ss += __shfl_xor(ss, 2); ss += __shfl_xor(ss, 4);
                const float inv = rsqrtf(ss * (1.0f / 96.0f) + EPS);
#pragma unroll
                for (int i = 0; i < 12; ++i) v[i] = v[i] * inv * kg[i];
                if (rope) { const float x1 = v[8], x2 = v[9], x3 = v[10], x4 = v[11];
                    v[8] = x1 * c0 - x2 * s0; v[9] = x2 * c0 + x1 * s0; v[10] = x3 * c1 - x4 * s1; v[11] = x4 * c1 + x3 * s1; }
                bf16_t* kd = K + ((size_t)base * 8 + (size_t)h * Sk + key) * 96;
#pragma unroll
                for (int i = 0; i < 12; ++i) kd[j + 8 * i] = (bf16_t)(pack2(v[i], 0.f) & 0xffffu);
            }
            {
                const u32x4 w = *(const u32x4*)(KVRAW + (size_t)r * 1024 + h * 128 + 64 + j * 8);
                *(LAS u32x4*)(Vs + (wave * 8 + rr) * 520 + lane * 8) = w;
            }
        }
        __syncthreads();
        {
            int base, key, Sk; seq_of_row(unit * 64, base, key, Sk);
            const int hh = tid >> 6, d = tid & 63;
            bf16_t* vd = VT + ((size_t)base * 8 + (size_t)hh * Sk) * 64 + (size_t)d * Sk + key;
#pragma unroll
            for (int q = 0; q < 8; ++q) { u32x4 w;
                w.x = (unsigned)Vs[(q * 8 + 0) * 520 + tid] | ((unsigned)Vs[(q * 8 + 1) * 520 + tid] << 16);
                w.y = (unsigned)Vs[(q * 8 + 2) * 520 + tid] | ((unsigned)Vs[(q * 8 + 3) * 520 + tid] << 16);
                w.z = (unsigned)Vs[(q * 8 + 4) * 520 + tid] | ((unsigned)Vs[(q * 8 + 5) * 520 + tid] << 16);
                w.w = (unsigned)Vs[(q * 8 + 6) * 520 + tid] | ((unsigned)Vs[(q * 8 + 7) * 520 + tid] << 16);
                *(u32x4*)(vd + q * 8) = w; }
        }
        __syncthreads();
    }
}

#define MFMA32(a, b, c) __builtin_amdgcn_mfma_f32_32x32x16_bf16((a), (b), (c), 0, 0, 0)
DI void attn_unit(const Params& p, int base, int Sk, int h, int qrow0, LAS unsigned char* lds, int tx) {
    const int tid = tx, lane = tid & 63, wave = tid >> 6, r32 = lane & 31, half = lane >> 5;
    const bf16_t* Q = (const bf16_t*)(p.ws + WS_R4);
    const bf16_t* Kg = (const bf16_t*)(p.ws + WS_K) + ((size_t)base * 8 + (size_t)h * Sk) * 96;
    const bf16_t* Vg = (const bf16_t*)(p.ws + WS_VT) + ((size_t)base * 8 + (size_t)h * Sk) * 64;
    float* O = (float*)(p.ws + WS_R3);
    LAS unsigned char* Ks = lds;
    LAS unsigned char* Vs = lds + 13312;
    const int qrow = qrow0 + wave * 32 + r32;
    bf16x8 Qf[6];
#pragma unroll
    for (int kk = 0; kk < 6; ++kk) Qf[kk] = *(const bf16x8*)(Q + ((size_t)qrow * 8 + h) * 96 + 16 * kk + 8 * half);
    const int kc0 = tid, kc1 = tid + 512;
    const int kr0 = kc0 / 12, kcc0 = kc0 % 12, kr1 = kc1 / 12, kcc1 = kc1 % 12;
    const bool has1 = kc1 < 768;
    const int vd = tid >> 3, vcc = tid & 7;
    f32x16 o0, o1;
#pragma unroll
    for (int i = 0; i < 16; ++i) { o0[i] = 0.f; o1[i] = 0.f; }
    float m = -1e30f, lsum = 0.f;
    const int nkt = Sk >> 6;
    u32x4 kreg0, kreg1 = {0u, 0u, 0u, 0u}, vreg;
    kreg0 = *(const u32x4*)(Kg + (size_t)kr0 * 96 + kcc0 * 8);
    if (has1) kreg1 = *(const u32x4*)(Kg + (size_t)kr1 * 96 + kcc1 * 8);
    vreg = *(const u32x4*)(Vg + (size_t)vd * Sk + vcc * 8);
    for (int kt = 0; kt < nkt; ++kt) {
        __syncthreads();
        *(LAS u32x4*)(Ks + kr0 * 208 + kcc0 * 16) = kreg0;
        if (has1) *(LAS u32x4*)(Ks + kr1 * 208 + kcc1 * 16) = kreg1;
        *(LAS u32x4*)(Vs + vd * 144 + vcc * 16) = vreg;
        __syncthreads();
        if (kt + 1 < nkt) {
            const bf16_t* kn = Kg + (size_t)(kt + 1) * 64 * 96;
            kreg0 = *(const u32x4*)(kn + (size_t)kr0 * 96 + kcc0 * 8);
            if (has1) kreg1 = *(const u32x4*)(kn + (size_t)kr1 * 96 + kcc1 * 8);
            vreg = *(const u32x4*)(Vg + (size_t)vd * Sk + (kt + 1) * 64 + vcc * 8);
        }
        f32x16 s0, s1;
#pragma unroll
        for (int i = 0; i < 16; ++i) { s0[i] = 0.f; s1[i] = 0.f; }
#pragma unroll
        for (int kk = 0; kk < 6; ++kk) {
            const bf16x8 a0 = *(const LAS bf16x8*)(Ks + r32 * 208 + (16 * kk + 8 * half) * 2);
            const bf16x8 a1 = *(const LAS bf16x8*)(Ks + (32 + r32) * 208 + (16 * kk + 8 * half) * 2);
            s0 = MFMA32(a0, Qf[kk], s0); s1 = MFMA32(a1, Qf[kk], s1);
        }
        float mx = s0[0];
#pragma unroll
        for (int i = 1; i < 16; ++i) mx = fmaxf(mx, s0[i]);
#pragma unroll
        for (int i = 0; i < 16; ++i) mx = fmaxf(mx, s1[i]);
        mx = fmaxf(mx, __shfl_xor(mx, 32));
        const float mnew = fmaxf(m, mx);
        const float alpha = __builtin_amdgcn_exp2f(m - mnew);
        m = mnew;
        float ps = 0.f;
#pragma unroll
        for (int i = 0; i < 16; ++i) { s0[i] = __builtin_amdgcn_exp2f(s0[i] - mnew); s1[i] = __builtin_amdgcn_exp2f(s1[i] - mnew); ps += s0[i] + s1[i]; }
        lsum = lsum * alpha + ps;
#pragma unroll
        for (int i = 0; i < 16; ++i) { o0[i] *= alpha; o1[i] *= alpha; }
#pragma unroll
        for (int kt2 = 0; kt2 < 2; ++kt2) {
#pragma unroll
            for (int s = 0; s < 2; ++s) {
                u32x4 pw;
                if (kt2 == 0) { pw.x = pack2(s0[8 * s], s0[8 * s + 1]); pw.y = pack2(s0[8 * s + 2], s0[8 * s + 3]); pw.z = pack2(s0[8 * s + 4], s0[8 * s + 5]); pw.w = pack2(s0[8 * s + 6], s0[8 * s + 7]); }
                else          { pw.x = pack2(s1[8 * s], s1[8 * s + 1]); pw.y = pack2(s1[8 * s + 2], s1[8 * s + 3]); pw.z = pack2(s1[8 * s + 4], s1[8 * s + 5]); pw.w = pack2(s1[8 * s + 6], s1[8 * s + 7]); }
                const bf16x8 pb = __builtin_bit_cast(bf16x8, pw);
                const int koff = (32 * kt2 + 16 * s + 4 * half) * 2;
                const s16x4 v0lo = *(const LAS s16x4*)(Vs + r32 * 144 + koff), v0hi = *(const LAS s16x4*)(Vs + r32 * 144 + koff + 16);
                const s16x4 v1lo = *(const LAS s16x4*)(Vs + (32 + r32) * 144 + koff), v1hi = *(const LAS s16x4*)(Vs + (32 + r32) * 144 + koff + 16);
                const bf16x8 va0 = __builtin_shufflevector(v0lo, v0hi, 0, 1, 2, 3, 4, 5, 6, 7), va1 = __builtin_shufflevector(v1lo, v1hi, 0, 1, 2, 3, 4, 5, 6, 7);
                o0 = MFMA32(va0, pb, o0); o1 = MFMA32(va1, pb, o1);
            }
        }
    }
    lsum += __shfl_xor(lsum, 32);
    const float inv = 1.0f / lsum;
    float* orow = O + (size_t)qrow * 512 + h * 64 + 4 * half;
#pragma unroll
    for (int g = 0; g < 4; ++g) {
        f32x4 a = {o0[4 * g] * inv, o0[4 * g + 1] * inv, o0[4 * g + 2] * inv, o0[4 * g + 3] * inv};
        f32x4 b = {o1[4 * g] * inv, o1[4 * g + 1] * inv, o1[4 * g + 2] * inv, o1[4 * g + 3] * inv};
        *(f32x4*)(orow + 8 * g) = a; *(f32x4*)(orow + 32 + 8 * g) = b;
    }
}
DI void attn_dispatch(const Params& p, int u, LAS unsigned char* lds, int tx) {
    if (u < 128) { const int b = u >> 5, h = (u >> 2) & 7, qb = u & 3; attn_unit(p, TC + b * 1280, 1280, h, TC + b * 1024 + qb * 256, lds, tx); }
    else { const int v = u - 128, sg = v >> 3, h = v & 7; attn_unit(p, sg * 256, 256, h, sg * 256, lds, tx); }
}
DI void phase_attn(const Params& p, LAS unsigned char* lds, int tx) {
    const int G = gridDim.x, b = blockIdx.x;
    if (G >= 256) {
        if (b < 128) attn_dispatch(p, b, lds, tx);
        else { const int nb = G - 128; for (int v = b - 128; v < 256; v += nb) attn_dispatch(p, 128 + v, lds, tx); }
    } else { for (int u = b; u < 384; u += G) attn_dispatch(p, u, lds, tx); }
}

DI float gelu_tanh(float x) { const float u = 0.7978845608028654f * (x + 0.044715f * x * x * x); const float e = __expf(2.0f * u); const float t = 1.0f - 2.0f / (e + 1.0f); return 0.5f * x * (1.0f + t); }
DI void phase_mix_finalize(const Params& p, int l, int tx) {
    const int lane = tx & 63, wave = tx >> 6;
    const bf16_t* U = (const bf16_t*)(p.ws + WS_R1);
    const float* HF = (const float*)(p.ws + WS_HF); const float* HB = HF + (size_t)T * 256;
    const float* O = (const float*)(p.ws + WS_R3);
    bf16_t* Y = (bf16_t*)(p.ws + WS_R2);
    const float* cw = p.in[I_CONVW] + l * 3 * 256; const float* cb = p.in[I_CONVB] + l * 256;
    const float* gc = p.in[I_GNC] + l * 256; const float* gl = p.in[I_GNL] + l * 256; const float* gm = p.in[I_GNM] + l * 512;
    for (int r = blockIdx.x * 8 + wave; r < T; r += gridDim.x * 8) {
        const int s = (r < TC) ? (r & 255) : ((r - TC) & 1023), S = (r < TC) ? 256 : 1024;
        const int c = 4 * lane;
        {
            f32x4 acc = *(const f32x4*)(cb + c);
#pragma unroll
            for (int k = 0; k < 3; ++k) { const int sk = s + k - 1;
                if (sk >= 0 && sk < S) { const bf16_t* u = U + (size_t)(r + k - 1) * INWP;
                    const u32x2 cg = *(const u32x2*)(u + 256 + c), hh = *(const u32x2*)(u + 512 + c); const f32x4 wv = *(const f32x4*)(cw + k * 256 + c);
                    acc[0] += wv[0] * (bflo(cg.x) * bflo(hh.x)); acc[1] += wv[1] * (bfhi(cg.x) * bfhi(hh.x)); acc[2] += wv[2] * (bflo(cg.y) * bflo(hh.y)); acc[3] += wv[3] * (bfhi(cg.y) * bfhi(hh.y)); } }
            const u32x2 bg = *(const u32x2*)(U + (size_t)r * INWP + c);
            f32x4 y = {bflo(bg.x) * acc[0], bfhi(bg.x) * acc[1], bflo(bg.y) * acc[2], bfhi(bg.y) * acc[3]};
            const float ss = wave_sum(y[0] * y[0] + y[1] * y[1] + y[2] * y[2] + y[3] * y[3]);
            const float inv = rsqrtf(ss * (1.0f / 256.0f) + EPS);
            const f32x4 g = *(const f32x4*)(gc + c);
            u32x2 o; o.x = pack2(y[0] * inv * g[0], y[1] * inv * g[1]); o.y = pack2(y[2] * inv * g[2], y[3] * inv * g[3]);
            *(u32x2*)(Y + (size_t)r * D + c) = o;
        }
        {
            const f32x4 hf = *(const f32x4*)(HF + (size_t)r * 256 + c), hb = *(const f32x4*)(HB + (size_t)r * 256 + c);
            const u32x2 yb = *(const u32x2*)(U + (size_t)r * INWP + 768 + 256 + c);
            f32x4 y = {(hf[0] + hb[0]) * gelu_tanh(bflo(yb.x)), (hf[1] + hb[1]) * gelu_tanh(bfhi(yb.x)), (hf[2] + hb[2]) * gelu_tanh(bflo(yb.y)), (hf[3] + hb[3]) * gelu_tanh(bfhi(yb.y))};
            const float ss = wave_sum(y[0] * y[0] + y[1] * y[1] + y[2] * y[2] + y[3] * y[3]);
            const float inv = rsqrtf(ss * (1.0f / 256.0f) + EPS);
            const f32x4 g = *(const f32x4*)(gl + c);
            u32x2 o; o.x = pack2(y[0] * inv * g[0], y[1] * inv * g[1]); o.y = pack2(y[2] * inv * g[2], y[3] * inv * g[3]);
            *(u32x2*)(Y + (size_t)r * D + 256 + c) = o;
        }
        {
            const f32x4 a = *(const f32x4*)(O + (size_t)r * 512 + c), b = *(const f32x4*)(O + (size_t)r * 512 + 256 + c);
            const float ss = wave_sum(a[0] * a[0] + a[1] * a[1] + a[2] * a[2] + a[3] * a[3] + b[0] * b[0] + b[1] * b[1] + b[2] * b[2] + b[3] * b[3]);
            const float inv = rsqrtf(ss * (1.0f / 512.0f) + EPS);
            const f32x4 g0 = *(const f32x4*)(gm + c), g1 = *(const f32x4*)(gm + 256 + c);
            u32x2 o; o.x = pack2(a[0] * inv * g0[0], a[1] * inv * g0[1]); o.y = pack2(a[2] * inv * g0[2], a[3] * inv * g0[3]);
            *(u32x2*)(Y + (size_t)r * D + 512 + c) = o;
            o.x = pack2(b[0] * inv * g1[0], b[1] * inv * g1[1]); o.y = pack2(b[2] * inv * g1[2], b[3] * inv * g1[3]);
            *(u32x2*)(Y + (size_t)r * D + 768 + c) = o;
        }
    }
}

struct EpiResGate {
    static constexpr bool PERM = false, AFTER_DRAIN = false;
    const float* xa; const float* xb; float* out; const float* gate;
    __device__ __forceinline__ void operator()(const pg8::f32x4 (&acc)[2][2][4][2], const pg8::Unit& u, int wr, int wc, int fr, int fq) const {
        const int row0 = u.pm * 256 + wr * 64 + fr, col0 = u.pn * 256 + wc * 32 + 4 * fq;
        const int ci = (u.pm < 32) ? 0 : 1 + ((u.pm - 32) >> 2);
        const float* xin = (u.pm < 32) ? xa : (xb - (size_t)TC * D);
        pg8::f32x4 gv[2][2];
#pragma unroll
        for (int bj = 0; bj < 2; ++bj)
#pragma unroll
            for (int n = 0; n < 2; ++n) gv[bj][n] = *(const pg8::f32x4*)(gate + ci * 6144 + col0 + bj * 128 + n * 16);
#pragma unroll
        for (int ai = 0; ai < 2; ++ai)
#pragma unroll
            for (int m = 0; m < 4; ++m) { const size_t off = (size_t)(row0 + ai * 128 + m * 16) * D + col0;
#pragma unroll
                for (int bj = 0; bj < 2; ++bj)
#pragma unroll
                    for (int n = 0; n < 2; ++n) { const pg8::f32x4 xv = *(const pg8::f32x4*)(xin + off + bj * 128 + n * 16);
                        *(pg8::f32x4*)(out + off + bj * 128 + n * 16) = xv + gv[bj][n] * acc[ai][bj][m][n]; } }
    }
};
struct EpiSwiGLU {
    static constexpr bool PERM = false, AFTER_DRAIN = false;
    bf16_t* G;
    __device__ __forceinline__ void operator()(const pg8::f32x4 (&acc)[2][2][4][2], const pg8::Unit& u, int wr, int wc, int fr, int fq) const {
        const int row0 = u.pm * 256 + wr * 64 + fr, colg0 = u.pn * 128 + wc * 16 + 4 * fq;
#pragma unroll
        for (int ai = 0; ai < 2; ++ai)
#pragma unroll
            for (int m = 0; m < 4; ++m) { bf16_t* rowp = G + (size_t)(row0 + ai * 128 + m * 16) * FF + colg0;
#pragma unroll
                for (int bj = 0; bj < 2; ++bj) { const pg8::f32x4 g = acc[ai][bj][m][0], up = acc[ai][bj][m][1];
                    float y[4];
#pragma unroll
                    for (int i = 0; i < 4; ++i) y[i] = g[i] / (1.0f + __expf(-g[i])) * up[i];
                    u32x2 w; w.x = pack2(y[0], y[1]); w.y = pack2(y[2], y[3]);
                    *(u32x2*)(rowp + bj * 64) = w; } }
    }
};

template <class Epi> DI void run_gemm(LAS unsigned char* lds, const bf16_t* A, const bf16_t* Bt, int M, int N, int K, const Epi& E, int tx) {
    pg8::Gemm g{A, Bt, M, N, K}; pg8::StaticOrder S; S.init(M, N, (int)gridDim.x, (int)blockIdx.x);
    pg8::gemm_phase<Epi, pg8::StaticOrder, false>(lds, g, S, E, nullptr, tx);
}

__global__ void __launch_bounds__(NT, 2) fwd_megakernel(Params p) {
    extern __shared__ __attribute__((aligned(16))) unsigned char shm[];
    LAS unsigned char* lds = (LAS unsigned char*)shm;
    cg::grid_group grid = cg::this_grid();
    unsigned char* ws = p.ws;
    for (int ph = p.ph_lo; ph < p.ph_hi; ++ph) {
        int tx = threadIdx.x; asm volatile("" : "+v"(tx));
        if (ph == 0) { phase_mod(p, lds, tx); }
        else {
            const int l = (ph - 1) / 11, k = (ph - 1) % 11;
            const float* modl = (const float*)(ws + WS_MOD) + (size_t)l * 5 * 6144;
            const float* xa = (l == 0) ? p.in[I_XP] : p.out; const float* xb = (l == 0) ? p.in[I_XS] : p.out + (size_t)TC * D;
            switch (k) {
            case 0: phase_convert(p, l, lds, tx); phase_prep(p, xa, xb, p.in[I_N1G] + l * D, modl, 0, 1024, tx); break;
            case 1: { pg8::EpiBf16<0> E{(bf16_t*)(ws + WS_R1), INWP, nullptr, 0, 0}; run_gemm(lds, (const bf16_t*)(ws + WS_R2), (const bf16_t*)(ws + WS_WT_IN), T, INWP, 1024, E, tx); } break;
            case 2: phase_post_in(p, l, tx); break;
            case 3: {
                phase_scan(p, l, lds, tx);
                { pg8::EpiBf16<0> E{(bf16_t*)(ws + WS_R3), 768, nullptr, 0, 0}; run_gemm(lds, (const bf16_t*)(ws + WS_R4), (const bf16_t*)(ws + WS_WT_QUP), T, 768, 256, E, tx); }
                { pg8::EpiBf16<0> E{(bf16_t*)(ws + WS_KVRAW), 1024, nullptr, 0, 0}; run_gemm(lds, (const bf16_t*)(ws + WS_CKV), (const bf16_t*)(ws + WS_WT_KVUP), TKV, 1024, 256, E, tx); }
            } break;
            case 4: phase_qk_finalize(p, l, lds, tx); break;
            case 5: phase_attn(p, lds, tx); break;
            case 6: phase_mix_finalize(p, l, tx); break;
            case 7: { EpiResGate E{xa, xb, p.out, modl + 2048}; run_gemm(lds, (const bf16_t*)(ws + WS_R2), (const bf16_t*)(ws + WS_WT_OUT), T, 1024, 1024, E, tx); } break;
            case 8: phase_prep(p, p.out, p.out + (size_t)TC * D, p.in[I_N2G] + l * D, modl, 3072, 4096, tx); break;
            case 9: { EpiSwiGLU E{(bf16_t*)(ws + WS_R1)}; run_gemm(lds, (const bf16_t*)(ws + WS_R2), (const bf16_t*)(ws + WS_WT_GU), T, 2 * FF, 1024, E, tx); } break;
            case 10: { EpiResGate E{p.out, p.out + (size_t)TC * D, p.out, modl + 5120}; run_gemm(lds, (const bf16_t*)(ws + WS_R1), (const bf16_t*)(ws + WS_WT_DN), T, 1024, FF, E, tx); } break;
            }
        }
        if (ph + 1 < p.ph_hi) grid.sync();
    }
}

extern "C" void kernel_launch(void* const* d_in, const int* in_sizes, int n_in, void* d_out, int out_size, void* d_ws, size_t ws_size, hipStream_t stream) {
    static int grid_blocks = 0;
    if (!grid_blocks) {
        int dev = 0, cus = 0, per_cu = 0;
        hipGetDevice(&dev);
        hipDeviceGetAttribute(&cus, hipDeviceAttributeMultiprocessorCount, dev);
        hipFuncSetAttribute((const void*)fwd_megakernel, hipFuncAttributeMaxDynamicSharedMemorySize, LDS_BYTES);
        hipOccupancyMaxActiveBlocksPerMultiprocessor(&per_cu, (const void*)fwd_megakernel, NT, LDS_BYTES);
        if (per_cu < 1) per_cu = 1;
        if (per_cu > 1) per_cu = 1;
        grid_blocks = cus * per_cu;
        if (ws_size < WS_END) fprintf(stderr, "kernel_launch: workspace too small: %zu < %zu\n", ws_size, (size_t)WS_END);
    }
    Params p{};
    for (int i = 0; i < 34; ++i) p.in[i] = (const float*)d_in[i];
    p.out = (float*)d_out; p.ws = (unsigned char*)d_ws; p.ph_lo = 0; p.ph_hi = 23;
    void* args[] = {&p};
    hipError_t e = hipLaunchCooperativeKernel((const void*)fwd_megakernel, dim3(grid_blocks), dim3(NT), args, LDS_BYTES, stream);
    if (e != hipSuccess) fprintf(stderr, "cooperative launch failed: %s (grid %d)\n", hipGetErrorString(e), grid_blocks);
}
```

```cpp
#include <hip/hip_runtime.h>
#include <hip/hip_cooperative_groups.h>
#include <cstdio>
namespace cg = cooperative_groups;

namespace pg8 {
#define PG8_LAS __attribute__((address_space(3)))
typedef unsigned short bf16_t;
typedef short bf16x8 __attribute__((ext_vector_type(8)));
typedef float f32x4 __attribute__((ext_vector_type(4)));
typedef unsigned u32x4 __attribute__((ext_vector_type(4)));
constexpr int BM = 256, BK = 64, HALF = 128, HTB = HALF * BK * 2  , STAGE_BYTES = 8 * HTB, NXCD = 8, WGM = 8;

__host__ __device__ __forceinline__ int lds_byte(int r, int c) { const int st = (r >> 4) * 2 + (c >> 5), rr = r & 15, cc = c & 31, ob = rr * 64 + cc * 2; return st * 1024 + (ob ^ (((ob >> 9) & 1) << 5)); }
__host__ __device__ __forceinline__ void stage_rc(int b, int& R, int& C) { const int st = b / 1024, sb = b % 1024, swz = sb ^ (((sb >> 9) & 1) << 5); R = (st >> 1) * 16 + swz / 64; C = (st & 1) * 32 + (swz % 64) / 2; }
__host__ __device__ __forceinline__ int perm32(int rho) { const int n = rho >> 4, i = rho & 15; return 8 * (i >> 2) + 4 * n + (i & 3); }

struct Unit { int pm, pn; };
struct Gemm { const bf16_t* A; const bf16_t* Bt; int M, N, K; };

struct StaticOrder {
    int nM, nN, nwg, G, c;
    __host__ __device__ void init(int M, int N, int G_, int c_) { nM = M / BM; nN = N / BM; nwg = nM * nN; G = G_; c = c_; }
    __host__ __device__ bool next(int i, Unit& u) const {
        const long L = (long)i * G + c; if (L >= nwg) return false;
        int wgid = (int)L; { const int q = nwg / NXCD, r = nwg % NXCD, xcd = wgid % NXCD, off = wgid / NXCD; wgid = (xcd < r ? xcd * (q + 1) : r * (q + 1) + (xcd - r) * q) + off; }
        const int nig = WGM * nN, gid = wgid / nig, fm = gid * WGM, gsz = (nM - fm) < WGM ? (nM - fm) : WGM;
        u.pm = fm + ((wgid % nig) % gsz); u.pn = (wgid % nig) / gsz; return true;
    }
    __device__ __forceinline__ void a_ready(const Unit&) const {}
    __device__ __forceinline__ void done(const Unit&) const {}
};
__device__ __forceinline__ unsigned cvt_pk_bf16(float lo, float hi) { unsigned r; asm volatile("v_cvt_pk_bf16_f32 %0, %1, %2" : "=v"(r) : "v"(lo), "v"(hi)); return r; }
typedef float f32x2 __attribute__((ext_vector_type(2)));
__device__ __forceinline__ f32x2 gelu_pk(f32x2 v) {
    const f32x2 av = __builtin_elementwise_abs(v), d = av * 0.2316418882f + 1.0f;
    f32x2 t; t.x = __builtin_amdgcn_rcpf(d.x); t.y = __builtin_amdgcn_rcpf(d.y);
    f32x2 q = t * 0.5307027145f + (-0.7265760135f); q = q * t + 0.7107068705f; q = q * t + (-0.142248368f); q = q * t + 0.127414796f; q = q * t;
    const f32x2 s = (v * v) * (-0.72134752044f);
    f32x2 e; e.x = __builtin_amdgcn_exp2f(s.x); e.y = __builtin_amdgcn_exp2f(s.y);
    const f32x2 m = v * (q * e), r = v - m;
    f32x2 o; o.x = v.x < 0.f ? m.x : r.x; o.y = v.y < 0.f ? m.y : r.y; return o;
}
template <int ACT  > struct EpiBf16 {
    static constexpr bool PERM = true, AFTER_DRAIN = false;
    bf16_t* O; int ldc; const float* bias; int split_cols; size_t split_stride;
    __device__ __forceinline__ void operator()(const f32x4 (&acc)[2][2][4][2], const Unit& u, int wr, int wc, int fr, int fq) const {
        const int row0 = u.pm * BM + wr * 64 + fr; int colt = u.pn * BM; bf16_t* base = O;
        if (split_cols) { const int t = colt / split_cols; base += (size_t)t * split_stride; colt -= t * split_cols; }
        const int col0 = colt + wc * 32 + 8 * fq, bcol0 = u.pn * BM + wc * 32 + 8 * fq;
        f32x4 bv[2][2];
#pragma unroll
        for (int bj = 0; bj < 2; ++bj)
#pragma unroll
            for (int n = 0; n < 2; ++n) bv[bj][n] = bias ? *(const f32x4*)(bias + bcol0 + bj * HALF + 4 * n) : (f32x4){0.f, 0.f, 0.f, 0.f};
#pragma unroll
        for (int ai = 0; ai < 2; ++ai)
#pragma unroll
            for (int m = 0; m < 4; ++m) { bf16_t* rowp = base + (size_t)(row0 + ai * HALF + m * 16) * ldc + col0;
#pragma unroll
                for (int bj = 0; bj < 2; ++bj) { f32x4 v0 = acc[ai][bj][m][0] + bv[bj][0], v1 = acc[ai][bj][m][1] + bv[bj][1];
                    if (ACT == 1) { f32x2 a = gelu_pk((f32x2){v0[0], v0[1]}), b = gelu_pk((f32x2){v0[2], v0[3]}), c = gelu_pk((f32x2){v1[0], v1[1]}), d = gelu_pk((f32x2){v1[2], v1[3]});
                        v0 = (f32x4){a.x, a.y, b.x, b.y}; v1 = (f32x4){c.x, c.y, d.x, d.y}; }
                    if (ACT == 2) {
#pragma unroll
                        for (int j = 0; j < 4; ++j) { v0[j] = 0.5f * v0[j] * (1.0f + erff(v0[j] * 0.70710678f)); v1[j] = 0.5f * v1[j] * (1.0f + erff(v1[j] * 0.70710678f)); } }
                    u32x4 w; w.x = cvt_pk_bf16(v0[0], v0[1]); w.y = cvt_pk_bf16(v0[2], v0[3]); w.z = cvt_pk_bf16(v1[0], v1[1]); w.w = cvt_pk_bf16(v1[2], v1[3]);
                    *(u32x4*)(rowp + bj * HALF) = w; } }
    }
};
template <class Epi, class Sched, bool STAMP = false>
__device__ __forceinline__ void gemm_phase(PG8_LAS unsigned char* lds, const Gemm g, const Sched& S, const Epi& E, unsigned long long* stamps, int tid_in) {
    const int tid = tid_in, wid = __builtin_amdgcn_readfirstlane(tid >> 6), lane = tid & 63, wr = wid >> 2, wc = wid & 3, fr = lane & 15, fq = lane >> 4;
    const int K = g.K, nt = K / BK;
    int ts_lo = 0, ts_hi = 0, nts = 0; const unsigned long long rt_entry = STAMP ? (unsigned long long)wall_clock64() : 0ull;
#define PG8_STAMP() do { if (STAMP && wid == 0 && nts < 64) { const unsigned long long _c = (unsigned long long)clock64(); \
        ts_lo = (lane == nts) ? (int)(unsigned)_c : ts_lo; ts_hi = (lane == nts) ? (int)(unsigned)(_c >> 32) : ts_hi; ++nts; } } while (0)
    PG8_STAMP();
    unsigned voffA[2], voffB[2];
#pragma unroll
    for (int i = 0; i < 2; ++i) { int R, C; stage_rc(tid * 16 + i * 8192, R, C); const int Rb = Epi::PERM ? ((R & ~31) + perm32(R & 31)) : R;
        voffA[i] = (unsigned)(R * K + C) * 2u; voffB[i] = (unsigned)(Rb * K + C) * 2u; }
    const size_t kstep = (size_t)(BK * 2);
    const size_t hstep = (size_t)HALF * K * 2;
    const size_t tstep = 2 * hstep;
    const unsigned ldsw = (unsigned)wid * 1024u;
    const int aoff = lds_byte(wr * 64 + fr, fq * 8), boff = lds_byte(wc * 32 + fr, fq * 8);
#define PG8_SA(b, h) (((b) * 2 + (h)) * HTB)
#define PG8_SB(b, h) ((4 + (b) * 2 + (h)) * HTB)
#define PG8_STAGE(bufoff, gbase, voff) do { _Pragma("unroll") for (int _i = 0; _i < 2; ++_i) \
        __builtin_amdgcn_global_load_lds((const unsigned*)((const char*)(gbase) + (voff)[_i]), (PG8_LAS unsigned*)(lds + (bufoff) + ldsw + _i * 8192), 16, 0, 0); } while (0)
#define PG8_LDA(dst, b, h) do { _Pragma("unroll") for (int m = 0; m < 4; ++m) _Pragma("unroll") for (int k = 0; k < 2; ++k) dst[m][k] = *(const PG8_LAS bf16x8*)(lds + PG8_SA(b, h) + aoff + m * 2048 + k * 1024); } while (0)
#define PG8_LDB(dst, b, h) do { _Pragma("unroll") for (int n = 0; n < 2; ++n) _Pragma("unroll") for (int k = 0; k < 2; ++k) dst[n][k] = *(const PG8_LAS bf16x8*)(lds + PG8_SB(b, h) + boff + n * 2048 + k * 1024); } while (0)
#define PG8_MMA(ai, bj, At, Bt) do { __builtin_amdgcn_s_setprio(1); _Pragma("unroll") for (int m = 0; m < 4; ++m) _Pragma("unroll") for (int n = 0; n < 2; ++n) _Pragma("unroll") for (int k = 0; k < 2; ++k) \
        acc[ai][bj][m][n] = __builtin_amdgcn_mfma_f32_16x16x32_bf16(Bt[n][k], At[m][k], acc[ai][bj][m][n], 0, 0, 0); __builtin_amdgcn_s_setprio(0); } while (0)
#define PG8_WAIT_V(n) asm volatile("s_waitcnt vmcnt(" #n ")" ::: "memory")
#define PG8_WAIT_L(n) asm volatile("s_waitcnt lgkmcnt(" #n ")" ::: "memory")
#define PG8_BAR __builtin_amdgcn_s_barrier()
#define PG8_SCHED __builtin_amdgcn_sched_barrier(0)
    Unit cur, nxt; int ui = 0;
    if (!S.next(0, cur)) return;
    f32x4 acc[2][2][4][2];
#pragma unroll
    for (int a = 0; a < 2; ++a)
#pragma unroll
        for (int b = 0; b < 2; ++b)
#pragma unroll
            for (int m = 0; m < 4; ++m)
#pragma unroll
                for (int n = 0; n < 2; ++n) acc[a][b][m][n] = (f32x4){0.f, 0.f, 0.f, 0.f};
    bf16x8 At[4][2], B0[2][2], B1[2][2];
    const char* cA = (const char*)g.A + (size_t)cur.pm * tstep; const char* cB = (const char*)g.Bt + (size_t)cur.pn * tstep;
    S.a_ready(cur);
    PG8_STAGE(PG8_SB(0, 0), cB, voffB); PG8_STAGE(PG8_SA(0, 0), cA, voffA); PG8_STAGE(PG8_SB(0, 1), cB + hstep, voffB); PG8_STAGE(PG8_SA(0, 1), cA + hstep, voffA);
    if (wr == 1) PG8_BAR;
    PG8_WAIT_V(4); PG8_BAR;
    PG8_STAGE(PG8_SB(1, 0), cB + kstep, voffB); PG8_STAGE(PG8_SA(1, 0), cA + kstep, voffA); PG8_STAGE(PG8_SB(1, 1), cB + hstep + kstep, voffB);
    PG8_WAIT_V(6); PG8_BAR;
    PG8_STAMP();
    for (;;) {
        const bool has_next = S.next(ui + 1, nxt);
        const char* nA = has_next ? (const char*)g.A + (size_t)nxt.pm * tstep : cA; const char* nB = has_next ? (const char*)g.Bt + (size_t)nxt.pn * tstep : cB;
        for (int t = 0; t < nt; t += 2) {
            const bool last = (t == nt - 2);
            const char* a1 = cA + (size_t)(t + 1) * kstep;
            const char* a2 = last ? nA : cA + (size_t)(t + 2) * kstep; const char* b2 = last ? nB : cB + (size_t)(t + 2) * kstep;
            const char* a3 = a2 + kstep; const char* b3 = b2 + kstep;
            if (last && has_next) S.a_ready(nxt);
            PG8_LDB(B0, 0, 0); PG8_SCHED; PG8_LDA(At, 0, 0); PG8_STAGE(PG8_SA(1, 1), a1 + hstep, voffA);
            PG8_WAIT_L(8); PG8_BAR; PG8_WAIT_L(0); PG8_MMA(0, 0, At, B0); PG8_BAR; PG8_SCHED;
            PG8_LDB(B1, 0, 1); PG8_STAGE(PG8_SB(0, 0), b2, voffB);
            PG8_BAR; PG8_WAIT_L(0); PG8_MMA(0, 1, At, B1); PG8_BAR;
            PG8_LDA(At, 0, 1); PG8_STAGE(PG8_SA(0, 0), a2, voffA);
            PG8_BAR; PG8_WAIT_L(0); PG8_MMA(1, 0, At, B0); PG8_BAR; PG8_SCHED;
            PG8_STAGE(PG8_SB(0, 1), b2 + hstep, voffB);
            PG8_WAIT_V(6); PG8_BAR; PG8_MMA(1, 1, At, B1); PG8_BAR;
            PG8_LDB(B0, 1, 0); PG8_SCHED; PG8_LDA(At, 1, 0); PG8_STAGE(PG8_SA(0, 1), a2 + hstep, voffA);
            PG8_WAIT_L(8); PG8_BAR; PG8_WAIT_L(0); PG8_MMA(0, 0, At, B0); PG8_BAR; PG8_SCHED;
            PG8_LDB(B1, 1, 1); PG8_STAGE(PG8_SB(1, 0), b3, voffB);
            PG8_BAR; PG8_WAIT_L(0); PG8_MMA(0, 1, At, B1); PG8_BAR;
            PG8_LDA(At, 1, 1); PG8_STAGE(PG8_SA(1, 0), a3, voffA);
            PG8_BAR; PG8_WAIT_L(0); PG8_MMA(1, 0, At, B0); PG8_BAR; PG8_SCHED;
            PG8_STAGE(PG8_SB(1, 1), b3 + hstep, voffB);
            PG8_WAIT_V(6); PG8_BAR; PG8_MMA(1, 1, At, B1); PG8_BAR;
        }
        PG8_STAMP();
        if constexpr (!Epi::AFTER_DRAIN) { unsigned zl_ = 0u; asm volatile("" : "+v"(zl_)); const int l2_ = (int)__builtin_amdgcn_mbcnt_hi(~0u, __builtin_amdgcn_mbcnt_lo(~0u, zl_));
            E(acc, cur, wr, wc, l2_ & 15, l2_ >> 4); S.done(cur); }
        PG8_STAMP();
        if (!has_next) break;
#pragma unroll
        for (int a = 0; a < 2; ++a)
#pragma unroll
            for (int b = 0; b < 2; ++b)
#pragma unroll
                for (int m = 0; m < 4; ++m)
#pragma unroll
                    for (int n = 0; n < 2; ++n) acc[a][b][m][n] = (f32x4){0.f, 0.f, 0.f, 0.f};
        cur = nxt; cA = nA; cB = nB; ++ui;
    }
    PG8_WAIT_V(0);
    if (wr == 0) PG8_BAR;
    PG8_BAR;
    if constexpr (Epi::AFTER_DRAIN) { E.fused(acc, cur, wr, wc, fr, fq, lds, wid, lane); S.done(cur); }
    PG8_STAMP();
    if (STAMP && wid == 0) { stamps[lane] = lane < nts ? (((unsigned long long)(unsigned)ts_hi << 32) | (unsigned)ts_lo) : 0ull;
        if (lane == 62) stamps[62] = rt_entry; if (lane == 63) stamps[63] = (unsigned long long)wall_clock64(); }
#undef PG8_STAMP
#undef PG8_SA
#undef PG8_SB
#undef PG8_STAGE
#undef PG8_LDA
#undef PG8_LDB
#undef PG8_MMA
#undef PG8_WAIT_V
#undef PG8_WAIT_L
#undef PG8_BAR
#undef PG8_SCHED
}
}

#define DI __device__ __forceinline__
#define LAS __attribute__((address_space(3)))
typedef unsigned short bf16_t;
typedef short bf16x8 __attribute__((ext_vector_type(8)));
typedef short s16x4 __attribute__((ext_vector_type(4)));
typedef float f32x4 __attribute__((ext_vector_type(4)));
typedef float f32x16 __attribute__((ext_vector_type(16)));
typedef unsigned u32x4 __attribute__((ext_vector_type(4)));
typedef unsigned u32x2 __attribute__((ext_vector_type(2)));

#ifndef PREFIX
#define PREFIX 0
#endif
#ifndef PFLAG
#define PFLAG 0
#endif
#ifndef RMASK
#define RMASK 0
#endif
#define FRESH_TX(name) unsigned name##_z = 0u; asm volatile("" : "+v"(name##_z)); const int name = wv64 + (int)__builtin_amdgcn_mbcnt_hi(~0u, __builtin_amdgcn_mbcnt_lo(~0u, name##_z))
#define REP(bit, ...) do { __VA_ARGS__; if ((RMASK >> (bit)) & 1) { __syncthreads(); __VA_ARGS__; } } while (0)
constexpr int NT = 512;
constexpr int D = 1024, TC = 8192, TLAT = 4096, T = TC + TLAT, TKV = T + 1024;
constexpr int INW = 1696, INWP = 1792, FF = 2816;
constexpr int LDS_STAGE = 131072, LDS_BYTES = LDS_STAGE + 16;
constexpr float EPS = 1e-6f;
constexpr float QSCALE = 0.10206207261596577f * 1.4426950408889634f;

constexpr size_t WS_WT_IN = 0;
constexpr size_t WS_WT_QUP = WS_WT_IN + (size_t)INWP * 1024 * 2;
constexpr size_t WS_WT_KVUP = WS_WT_QUP + (size_t)768 * 256 * 2;
constexpr size_t WS_WT_OUT = WS_WT_KVUP + (size_t)1024 * 256 * 2;
constexpr size_t WS_WT_GU = WS_WT_OUT + (size_t)1024 * 1024 * 2;
constexpr size_t WS_WT_DN = WS_WT_GU + (size_t)2 * FF * 1024 * 2;
constexpr size_t WS_MOD = WS_WT_DN + (size_t)1024 * FF * 2;
constexpr size_t WS_R1 = WS_MOD + (size_t)2 * 5 * 6144 * 4;
constexpr size_t WS_XC = WS_R1 + (size_t)T * INWP * 2;
constexpr size_t WS_R2 = WS_R1 + (size_t)T * FF * 2;
constexpr size_t WS_R3 = WS_R2 + (size_t)T * 1024 * 2;
constexpr size_t WS_KVRAW = WS_R3 + (size_t)T * 768 * 2;
constexpr size_t WS_R4 = WS_KVRAW + (size_t)TKV * 1024 * 2;
constexpr size_t WS_CKV = WS_R4 + (size_t)T * 256 * 2;
constexpr size_t WS_K = WS_R4 + (size_t)T * 768 * 2;
constexpr size_t WS_VT = WS_K + (size_t)TKV * 768 * 2;
constexpr size_t WS_HF = WS_VT + (size_t)TKV * 512 * 2;
constexpr size_t WS_END = WS_HF + (size_t)2 * T * 256 * 4;
constexpr size_t WS_BAR = WS_END;
constexpr size_t WS_WT2 = WS_BAR + 16384;
constexpr size_t WS_RS = WS_WT2 + WS_MOD;
constexpr size_t WS_BIN = WS_RS + (size_t)4 * T * 4;
constexpr size_t WS_BGU = WS_BIN + (size_t)2 * 5 * INWP * 4;
constexpr size_t WS_WTAB = WS_BGU + (size_t)2 * 5 * 2 * FF * 4;
constexpr size_t WS_TOTAL = WS_WTAB + (size_t)2 * 2 * 5 * 1024 * 4;
static_assert(WS_TOTAL <= (size_t)256 * 1024 * 1024, "workspace too large");
static_assert((size_t)T * 256 * 2 + (size_t)TKV * 256 * 2 <= (size_t)T * 768 * 2, "QLAT+CKV must fit in Q region");

constexpr size_t OUT_CKV = (size_t)T * 1024, OUT_KR = OUT_CKV + (size_t)32 * 2 * 256 * 128, OUT_ST = OUT_KR + (size_t)32 * 2 * 256 * 32;

struct KParams { const float* in[34]; float* out; unsigned char* ws; int ph_lo, ph_hi; };
struct Params { const float* in[34]; float* out; unsigned char* ws; int bx, gx; };
enum { I_XP = 0, I_XS, I_CCKV, I_CKR, I_STATE, I_C, I_CCTX, I_N1G, I_ADAW, I_ADAB, I_WIN, I_CONVW, I_CONVB, I_LCW, I_LCB, I_LWA, I_LBA, I_LWI, I_LBI, I_LAM,
       I_QNG, I_WQUP, I_KVNG, I_WKVUP, I_QHG, I_KHG, I_GNC, I_GNL, I_GNM, I_WOUT, I_N2G, I_WG, I_WU, I_WD };

DI unsigned pack2(float lo, float hi) {
    typedef __bf16 bf2 __attribute__((ext_vector_type(2))); typedef float f2 __attribute__((ext_vector_type(2)));
    f2 v = {lo, hi}; bf2 b = __builtin_convertvector(v, bf2); return __builtin_bit_cast(unsigned, b);
}
DI float bf2f(unsigned short b) { return __uint_as_float(((unsigned)b) << 16); }
DI float bflo(unsigned w) { return __uint_as_float(w << 16); }
DI float bfhi(unsigned w) { return __uint_as_float(w & 0xffff0000u); }
DI float wave_sum(float v) {
#pragma unroll
    for (int o = 32; o >= 1; o >>= 1) v += __shfl_xor(v, o);
    return v;
}
#define MFMA32(a, b, c) __builtin_amdgcn_mfma_f32_32x32x16_bf16((a), (b), (c), 0, 0, 0)
DI float sigmoidf_(float x) { return 1.0f / (1.0f + __expf(-x)); }

DI void phase_mod(const Params& p, LAS unsigned char* lds, int tx, int lsel, int first, int nblk) {
    const int tid = tx;
    LAS float* sc = (LAS float*)lds;
    LAS float* red = (LAS float*)(lds + 20480);
    for (int i = tid; i < 5 * 1024; i += NT) { const int ci = i >> 10, k = i & 1023; const float v = (ci == 0) ? p.in[I_CCTX][k] : p.in[I_C][(ci - 1) * 1024 + k]; sc[i] = v / (1.0f + __expf(-v)); }
    __syncthreads();
    float* mod = (float*)(p.ws + WS_MOD);
    const int cg = tid & 15, kg = tid >> 4;
    for (int unit = first; unit < 96; unit += nblk) {
        const int l = lsel, n0 = unit * 64;
        const float* w = p.in[I_ADAW] + (size_t)l * 1024 * 6144 + n0 + 4 * cg;
        f32x4 a0 = {0.f, 0.f, 0.f, 0.f}, a1 = a0, a2 = a0, a3 = a0, a4 = a0;
#pragma unroll 8
        for (int k = kg * 32; k < kg * 32 + 32; ++k) { const f32x4 wv = *(const f32x4*)(w + (size_t)k * 6144); a0 += sc[k] * wv; a1 += sc[1024 + k] * wv; a2 += sc[2048 + k] * wv; a3 += sc[3072 + k] * wv; a4 += sc[4096 + k] * wv; }
#pragma unroll
        for (int q = 0; q < 4; ++q) { LAS float* r = red + (kg * 64 + 4 * cg + q) * 5; r[0] = a0[q]; r[1] = a1[q]; r[2] = a2[q]; r[3] = a3[q]; r[4] = a4[q]; }
        __syncthreads();
        if (tid < 320) { const int c = tid >> 6, c2 = tid & 63; float sum = 0.f;
#pragma unroll
            for (int g = 0; g < 32; ++g) sum += red[(g * 64 + c2) * 5 + c];
            mod[(size_t)(l * 5 + c) * 6144 + n0 + c2] = sum + p.in[I_ADAB][l * 6144 + n0 + c2]; }
        __syncthreads();
    }
}

DI void cvt_tile(const float* __restrict__ src, bf16_t* __restrict__ dst, int K, int N, int Kpad, int kt, int nt, int mode, LAS unsigned char* lds, int tx) {
    LAS float* tile = (LAS float*)lds;
    const int tid = tx, cx = tid & 63, ty = tid >> 6;
    float v[16];
#pragma unroll
    for (int i = 0; i < 16; ++i) { const int k = kt * 128 + ty + 8 * i, n = nt * 64 + cx; v[i] = (k < K && n < N) ? src[(size_t)k * N + n] : 0.f; }
#pragma unroll
    for (int i = 0; i < 16; ++i) tile[(ty + 8 * i) * 65 + cx] = v[i];
    __syncthreads();
#pragma unroll
    for (int it = 0; it < 2; ++it) {
        const int item = tid + 512 * it, nl = item >> 4, kc = (item & 15) * 8, n = nt * 64 + nl;
        u32x4 w;
        w.x = pack2(tile[(kc + 0) * 65 + nl], tile[(kc + 1) * 65 + nl]); w.y = pack2(tile[(kc + 2) * 65 + nl], tile[(kc + 3) * 65 + nl]);
        w.z = pack2(tile[(kc + 4) * 65 + nl], tile[(kc + 5) * 65 + nl]); w.w = pack2(tile[(kc + 6) * 65 + nl], tile[(kc + 7) * 65 + nl]);
        const int R = (mode == 0) ? n : (256 * (n >> 7) + 128 * (mode - 1) + (n & 127));
        *(u32x4*)(dst + (size_t)R * Kpad + kt * 128 + kc) = w;
    }
    __syncthreads();
}
DI void phase_convert(const Params& p, int l, LAS unsigned char* lds, int tx, int first, int nblk, int ulo = 0, int uhi = 1 << 30) {
    unsigned char* wsl = p.ws + (l ? WS_WT2 : 0);
    const int c0 = 8 * 28, c1 = c0 + 2 * 12, c2 = c1 + 2 * 16, c3 = c2 + 8 * 16, c4 = c3 + 8 * 44, c5 = c4 + 8 * 44, c6 = c5 + 22 * 16;
    for (int u = ulo + first; u < c6 && u < uhi; u += nblk) {
        if (u < c0)      { const int v = u;      cvt_tile(p.in[I_WIN] + (size_t)l * 1024 * INW, (bf16_t*)(wsl + WS_WT_IN), 1024, INW, 1024, v % 8, v / 8, 0, lds, tx); }
        else if (u < c1) { const int v = u - c0; cvt_tile(p.in[I_WQUP] + (size_t)l * 256 * 768, (bf16_t*)(wsl + WS_WT_QUP), 256, 768, 256, v % 2, v / 2, 0, lds, tx); }
        else if (u < c2) { const int v = u - c1; cvt_tile(p.in[I_WKVUP] + (size_t)l * 128 * 1024, (bf16_t*)(wsl + WS_WT_KVUP), 128, 1024, 256, v % 2, v / 2, 0, lds, tx); }
        else if (u < c3) { const int v = u - c2; cvt_tile(p.in[I_WOUT] + (size_t)l * 1024 * 1024, (bf16_t*)(wsl + WS_WT_OUT), 1024, 1024, 1024, v % 8, v / 8, 0, lds, tx); }
        else if (u < c4) { const int v = u - c3; cvt_tile(p.in[I_WG] + (size_t)l * 1024 * FF, (bf16_t*)(wsl + WS_WT_GU), 1024, FF, 1024, v % 8, v / 8, 1, lds, tx); }
        else if (u < c5) { const int v = u - c4; cvt_tile(p.in[I_WU] + (size_t)l * 1024 * FF, (bf16_t*)(wsl + WS_WT_GU), 1024, FF, 1024, v % 8, v / 8, 2, lds, tx); }
        else             { const int v = u - c5; cvt_tile(p.in[I_WD] + (size_t)l * FF * 1024, (bf16_t*)(wsl + WS_WT_DN), FF, 1024, FF, v % 22, v / 22, 0, lds, tx); }
    }
}

DI void phase_prep0(const Params& p, const float* __restrict__ xa, const float* __restrict__ xb, const float* __restrict__ g, const float* __restrict__ modl, int scoff, int tx) {
    const int lane = tx & 63, wave = tx >> 6;
    bf16_t* __restrict__ HN = (bf16_t*)(p.ws + WS_R2);
    float* __restrict__ rs = (float*)(p.ws + WS_RS);
    for (int rb = (p.bx * 8 + wave) * 3; rb < T; rb += p.gx * 8 * 3) {
        f32x4 v[3][4];
#pragma unroll
        for (int q = 0; q < 3; ++q) { const int r = rb + q; const float* x = (r < TC) ? xa + (size_t)r * D : xb + (size_t)(r - TC) * D;
#pragma unroll
            for (int i = 0; i < 4; ++i) v[q][i] = *(const f32x4*)(x + 4 * (lane + 64 * i)); }
#pragma unroll
        for (int q = 0; q < 3; ++q) { const int r = rb + q; const int ci = (r < TC) ? 0 : 1 + ((r - TC) >> 10);
            float ss = 0.f;
#pragma unroll
            for (int i = 0; i < 4; ++i) ss += v[q][i][0] * v[q][i][0] + v[q][i][1] * v[q][i][1] + v[q][i][2] * v[q][i][2] + v[q][i][3] * v[q][i][3];
            ss = wave_sum(ss);
            if (lane == 0) rs[r] = ss;
#pragma unroll
            for (int i = 0; i < 4; ++i) { const int col = 4 * (lane + 64 * i);
                const f32x4 gv = *(const f32x4*)(g + col), sc = *(const f32x4*)(modl + ci * 6144 + scoff + col);
                const f32x4 y = v[q][i] * (gv * (sc + 1.0f));
                u32x2 w; w.x = pack2(y[0], y[1]); w.y = pack2(y[2], y[3]);
                *(u32x2*)(HN + (size_t)r * D + col) = w; } }
    }
}
DI void phase_tables(const Params& p, int tx, int lsel) {
    float* wtab = (float*)(p.ws + WS_WTAB); const float* mod = (const float*)(p.ws + WS_MOD);
#pragma unroll
    for (int kq = 0; kq < 4; ++kq) { const int i = (kq * p.gx + p.bx) * NT + tx; if (i >= 2 * 2 * 5 * 1024) continue;
        const int col = i & 1023, ci = (i >> 10) % 5, which = ((i >> 10) / 5) & 1, l = (i >> 10) / 10; if (l != lsel) continue;
        const float g = (which ? p.in[I_N2G] : p.in[I_N1G])[l * 1024 + col];
        wtab[i] = g * (1.0f + mod[(size_t)(l * 5 + ci) * 6144 + (which ? 4096 : 1024) + col]);
    }
}
DI void phase_zero_rs(const Params& p, int tx) {
    float* rs = (float*)(p.ws + WS_RS) + T;
#pragma unroll
    for (int k = 0; k < 4; ++k) { const int i = (k * p.gx + p.bx) * NT + tx; if (i < 3 * T) rs[i] = 0.f; }
}
DI void bias_rows(const bf16_t* __restrict__ WT, const float* __restrict__ sh  , float* __restrict__ out, int N, int gw, int nw, int lane) {
    float sv[5][16];
#pragma unroll
    for (int ci = 0; ci < 5; ++ci)
#pragma unroll
        for (int i = 0; i < 4; ++i) { const f32x4 t = *(const f32x4*)(sh + ci * 6144 + lane * 16 + 4 * i); sv[ci][4 * i] = t[0]; sv[ci][4 * i + 1] = t[1]; sv[ci][4 * i + 2] = t[2]; sv[ci][4 * i + 3] = t[3]; }
    for (int n0 = gw * 4; n0 < N; n0 += nw * 4) {
        u32x4 w0[4], w1[4];
#pragma unroll
        for (int q = 0; q < 4; ++q) { w0[q] = *(const u32x4*)(WT + (size_t)(n0 + q) * 1024 + lane * 16); w1[q] = *(const u32x4*)(WT + (size_t)(n0 + q) * 1024 + lane * 16 + 8); }
#pragma unroll
        for (int q = 0; q < 4; ++q) {
            const float wf[16] = {bflo(w0[q].x), bfhi(w0[q].x), bflo(w0[q].y), bfhi(w0[q].y), bflo(w0[q].z), bfhi(w0[q].z), bflo(w0[q].w), bfhi(w0[q].w), bflo(w1[q].x), bfhi(w1[q].x), bflo(w1[q].y), bfhi(w1[q].y), bflo(w1[q].z), bfhi(w1[q].z), bflo(w1[q].w), bfhi(w1[q].w)};
            float d[5];
#pragma unroll
            for (int ci = 0; ci < 5; ++ci) { float a = 0.f;
#pragma unroll
                for (int i = 0; i < 16; ++i) a += sv[ci][i] * wf[i];
                d[ci] = a; }
#pragma unroll
            for (int o = 32; o >= 1; o >>= 1) { d[0] += __shfl_xor(d[0], o); d[1] += __shfl_xor(d[1], o); d[2] += __shfl_xor(d[2], o); d[3] += __shfl_xor(d[3], o); d[4] += __shfl_xor(d[4], o); }
            const float val = lane == 0 ? d[0] : lane == 1 ? d[1] : lane == 2 ? d[2] : lane == 3 ? d[3] : d[4];
            if (lane < 5) out[(size_t)lane * N + n0 + q] = val;
        }
    }
}
DI void phase_bias(const Params& p, int l, int first, int nblk, int tx, int parts = 3) {
    const int lane = tx & 63, wave = tx >> 6;
    const unsigned char* wt = p.ws + (l ? WS_WT2 : 0);
    const float* modl = (const float*)(p.ws + WS_MOD) + (size_t)l * 5 * 6144;
    if (parts & 1) bias_rows((const bf16_t*)(wt + WS_WT_IN), modl + 0, (float*)(p.ws + WS_BIN) + (size_t)l * 5 * INWP, INWP, first * 8 + wave, nblk * 8, lane);
    if (parts & 2) bias_rows((const bf16_t*)(wt + WS_WT_GU), modl + 3072, (float*)(p.ws + WS_BGU) + (size_t)l * 5 * 2 * FF, 2 * FF, first * 8 + wave, nblk * 8, lane);
}

DI void phase_post_in(const Params& p, int l, int tx) {
    const int lane = tx & 63, wave = tx >> 6;
    const bf16_t* __restrict__ U = (const bf16_t*)(p.ws + WS_R1);
    bf16_t* __restrict__ QLAT = (bf16_t*)(p.ws + WS_R4);
    bf16_t* __restrict__ CKV = (bf16_t*)(p.ws + WS_CKV);
    float* __restrict__ out = p.out;
    const f32x4 qgv = *(const f32x4*)(p.in[I_QNG] + l * 256 + 4 * lane);
    const float kg0 = p.in[I_KVNG][l * 128 + 2 * lane], kg1 = p.in[I_KVNG][l * 128 + 2 * lane + 1];
    for (int rb = (p.bx * 8 + wave) * 4; rb < T + 1024; rb += p.gx * 8 * 4) {
        if (rb < T) {
            u32x2 qw[4]; unsigned cw[4]; unsigned short kr[4];
#pragma unroll
            for (int q = 0; q < 4; ++q) { const bf16_t* u = U + (size_t)(rb + q) * INWP; qw[q] = *(const u32x2*)(u + 1280 + 4 * lane); cw[q] = *(const unsigned*)(u + 1536 + 2 * lane); kr[q] = u[1664 + (lane & 31)]; }
#pragma unroll
            for (int q = 0; q < 4; ++q) { const int r = rb + q;
                const float a = bflo(qw[q].x), b = bfhi(qw[q].x), c = bflo(qw[q].y), d = bfhi(qw[q].y), e = bflo(cw[q]), f = bfhi(cw[q]);
                float s1 = a * a + b * b + c * c + d * d, s2 = e * e + f * f;
#pragma unroll
                for (int o = 32; o >= 1; o >>= 1) { s1 += __shfl_xor(s1, o); s2 += __shfl_xor(s2, o); }
                const float i1 = rsqrtf(s1 * (1.0f / 256.0f) + EPS), i2 = rsqrtf(s2 * (1.0f / 128.0f) + EPS);
                u32x2 o; o.x = pack2(a * i1 * qgv[0], b * i1 * qgv[1]); o.y = pack2(c * i1 * qgv[2], d * i1 * qgv[3]);
                *(u32x2*)(QLAT + (size_t)r * 256 + 4 * lane) = o;
                const float y0 = e * i2 * kg0, y1 = f * i2 * kg1;
                *(unsigned*)(CKV + (size_t)r * 256 + 2 * lane) = pack2(y0, y1);
                *(unsigned*)(CKV + (size_t)r * 256 + 128 + 2 * lane) = 0u;
                if (r < TC) { const int b_ = r >> 8, sq = r & 255; typedef float f32x2_ __attribute__((ext_vector_type(2))); *(f32x2_*)(out + OUT_CKV + ((size_t)(b_ * 2 + l) * 256 + sq) * 128 + 2 * lane) = (f32x2_){y0, y1};
                    if (lane < 32) out[OUT_KR + ((size_t)(b_ * 2 + l) * 256 + sq) * 32 + lane] = bf2f(kr[q]); }
            }
        } else {
#pragma unroll
            for (int q = 0; q < 4; ++q) { const int r = rb + q, rc = r - T, b_ = rc >> 8, sq = rc & 255;
                const float* src = p.in[I_CCKV] + ((size_t)(b_ * 2 + l) * 256 + sq) * 128 + 2 * lane;
                *(unsigned*)(CKV + (size_t)r * 256 + 2 * lane) = pack2(src[0], src[1]);
                *(unsigned*)(CKV + (size_t)r * 256 + 128 + 2 * lane) = 0u; }
        }
    }
}

DI void gates_unit(const Params& p, int l, int tt128, int n, int dir, LAS unsigned char* lds, int tx, const bf16x8 (&wfa)[4], const bf16x8 (&wfi)[4], float ba, float bi, float sp) {
    const int tid = tx, lane = tid & 63, wave = tid >> 6, r32 = lane & 31, half = lane >> 5, tt = wave >> 1, jt = wave & 1;
    const bf16_t* __restrict__ U = (const bf16_t*)(p.ws + WS_R1);
    float* __restrict__ Ab = (float*)(p.ws + WS_R2) + (size_t)dir * T * 256;
    float* __restrict__ Bb = (float*)(p.ws + WS_XC) + (size_t)dir * T * 256;
    LAS float* xs = (LAS float*)lds;
    LAS unsigned char* xb = lds + 32768;
    const float* cw = p.in[I_LCW] + l * 4 * 256 + n * 64; const float* cb = p.in[I_LCB] + l * 256 + n * 64;
    const int r0 = tt128 * 128;
#pragma unroll
    for (int it = 0; it < 2; ++it) {
        const int item = tid + 512 * it, tl = item >> 3, cg = (item & 7) * 8, r = r0 + tl;
        const int s = (r < TC) ? (r & 255) : ((r - TC) & 1023), S = (r < TC) ? 256 : 1024;
        f32x4 a0 = *(const f32x4*)(cb + cg), a1 = *(const f32x4*)(cb + cg + 4);
#pragma unroll
        for (int k = 0; k < 4; ++k) { const int sk = s + k - 2;
            if (sk >= 0 && sk < S) { const u32x4 w = *(const u32x4*)(U + (size_t)(r + k - 2) * INWP + 768 + n * 64 + cg);
                const f32x4 w0 = *(const f32x4*)(cw + k * 256 + cg), w1 = *(const f32x4*)(cw + k * 256 + cg + 4);
                a0[0] += w0[0] * bflo(w.x); a0[1] += w0[1] * bfhi(w.x); a0[2] += w0[2] * bflo(w.y); a0[3] += w0[3] * bfhi(w.y);
                a1[0] += w1[0] * bflo(w.z); a1[1] += w1[1] * bfhi(w.z); a1[2] += w1[2] * bflo(w.w); a1[3] += w1[3] * bfhi(w.w); } }
        *(LAS f32x4*)(xs + tl * 64 + cg) = a0; *(LAS f32x4*)(xs + tl * 64 + cg + 4) = a1;
        u32x4 pw; pw.x = pack2(a0[0], a0[1]); pw.y = pack2(a0[2], a0[3]); pw.z = pack2(a1[0], a1[1]); pw.w = pack2(a1[2], a1[3]);
        *(LAS u32x4*)(xb + tl * 144 + cg * 2) = pw;
    }
    __syncthreads();
    f32x16 za, zi;
#pragma unroll
    for (int i = 0; i < 16; ++i) { za[i] = ba; zi[i] = bi; }
#pragma unroll
    for (int kk = 0; kk < 4; ++kk) {
        const bf16x8 af = *(const LAS bf16x8*)(xb + (tt * 32 + r32) * 144 + (kk * 16 + 8 * half) * 2);
        za = MFMA32(af, wfa[kk], za); zi = MFMA32(af, wfi[kk], zi);
    }
    const int c = n * 64 + jt * 32 + r32;
#pragma unroll
    for (int i = 0; i < 16; ++i) {
        const int tl = tt * 32 + (i & 3) + 8 * (i >> 2) + 4 * half, r = r0 + tl;
        const float xj = xs[tl * 64 + jt * 32 + r32];
        const float rr = __builtin_amdgcn_rcpf(1.0f + __builtin_amdgcn_exp2f(-1.4426950408889634f * za[i]));
        const float ii = __builtin_amdgcn_rcpf(1.0f + __builtin_amdgcn_exp2f(-1.4426950408889634f * zi[i]));
        const float la = -8.0f * rr * sp;
        const float a = __builtin_amdgcn_exp2f(1.4426950408889634f * la);
        const float bt = __builtin_amdgcn_sqrtf(-expm1f(2.0f * la)) * (ii * xj);
        Ab[(size_t)r * 256 + c] = a; Bb[(size_t)r * 256 + c] = bt;
    }
    __syncthreads();
}
DI void gates_load_w(const Params& p, int l, int n, int dir, int tx, bf16x8 (&wfa)[4], bf16x8 (&wfi)[4], float& ba, float& bi, float& sp) {
    const int lane = tx & 63, wave = tx >> 6, r32 = lane & 31, half = lane >> 5, jt = wave & 1, j = jt * 32 + r32;
    const float* wap = p.in[I_LWA] + ((size_t)((l * 2 + dir) * 4 + n) * 64) * 64 + j;
    const float* wip = p.in[I_LWI] + ((size_t)((l * 2 + dir) * 4 + n) * 64) * 64 + j;
#pragma unroll
    for (int kk = 0; kk < 4; ++kk) { u32x4 wa_, wi_; const int k0 = kk * 16 + 8 * half;
        wa_.x = pack2(wap[(k0 + 0) * 64], wap[(k0 + 1) * 64]); wa_.y = pack2(wap[(k0 + 2) * 64], wap[(k0 + 3) * 64]); wa_.z = pack2(wap[(k0 + 4) * 64], wap[(k0 + 5) * 64]); wa_.w = pack2(wap[(k0 + 6) * 64], wap[(k0 + 7) * 64]);
        wi_.x = pack2(wip[(k0 + 0) * 64], wip[(k0 + 1) * 64]); wi_.y = pack2(wip[(k0 + 2) * 64], wip[(k0 + 3) * 64]); wi_.z = pack2(wip[(k0 + 4) * 64], wip[(k0 + 5) * 64]); wi_.w = pack2(wip[(k0 + 6) * 64], wip[(k0 + 7) * 64]);
        wfa[kk] = __builtin_bit_cast(bf16x8, wa_); wfi[kk] = __builtin_bit_cast(bf16x8, wi_); }
    const int c = n * 64 + j;
    ba = p.in[I_LBA][(l * 2 + dir) * 256 + c]; bi = p.in[I_LBI][(l * 2 + dir) * 256 + c];
    sp = log1pf(__expf(-p.in[I_LAM][(l * 2 + dir) * 256 + c]));
}
DI void phase_gates(const Params& p, int l, LAS unsigned char* lds, int tx) {
    bf16x8 wfa[4], wfi[4]; float ba, bi, sp;
    if ((p.gx & 7) == 0) {
        const int n = (p.bx >> 1) & 3, dir = p.bx & 1;
        gates_load_w(p, l, n, dir, tx, wfa, wfi, ba, bi, sp);
        for (int u = p.bx; u < 96 * 8; u += p.gx) gates_unit(p, l, u >> 3, n, dir, lds, tx, wfa, wfi, ba, bi, sp);
    } else {
        for (int u = p.bx; u < 96 * 8; u += p.gx) { const int n = (u >> 1) & 3, dir = u & 1;
            gates_load_w(p, l, n, dir, tx, wfa, wfi, ba, bi, sp);
            gates_unit(p, l, u >> 3, n, dir, lds, tx, wfa, wfi, ba, bi, sp); }
    }
}
template <int CH, int LC> DI void scan_unit(const Params& p, int l, int sigma, int dir, int cbase, LAS unsigned char* lds, int tx) {
    constexpr int NCH = 512 / CH;
    const int tid = tx, j = tid % CH, chunk = tid / CH;
    const int S = LC * NCH, row0 = (sigma < 32) ? sigma * 256 : TC + (sigma - 32) * 1024;
    const int c = cbase + j;
    const float* __restrict__ Ab = (const float*)(p.ws + WS_R2) + (size_t)dir * T * 256 + c;
    const float* __restrict__ Bb = (const float*)(p.ws + WS_XC) + (size_t)dir * T * 256 + c;
    float* __restrict__ Hb = (float*)(p.ws + WS_HF) + (size_t)dir * T * 256 + c;
    const float h0 = (sigma < 32) ? 0.f : p.in[I_STATE][((size_t)((sigma - 32) * 2 + l) * 2 + dir) * 256 + c];
    const int tau0 = chunk * LC;
    const long step = dir ? -256 : 256;
    const long off0 = (long)(row0 + (dir ? (S - 1 - tau0) : tau0)) * 256;
    float av[LC], bv[LC];
#pragma unroll
    for (int q = 0; q < LC; ++q) { av[q] = Ab[off0 + (long)q * step]; bv[q] = Bb[off0 + (long)q * step]; }
    float H = 0.f, P = 1.f;
#pragma unroll
    for (int q = 0; q < LC; ++q) { H = av[q] * H + bv[q]; P *= av[q]; }
    LAS float* sP = (LAS float*)lds; LAS float* sH = sP + 512;
    sP[chunk * CH + j] = P; sH[chunk * CH + j] = H;
    __syncthreads();
    float h = h0;
    for (int cc = 0; cc < chunk; ++cc) h = sP[cc * CH + j] * h + sH[cc * CH + j];
#pragma unroll
    for (int q = 0; q < LC; ++q) { h = av[q] * h + bv[q]; Hb[off0 + (long)q * step] = h; }
    if (chunk == NCH - 1 && sigma < 32) p.out[OUT_ST + ((size_t)(sigma * 2 + l) * 2 + dir) * 256 + c] = h;
    __syncthreads();
}
DI void phase_scan(const Params& p, int l, LAS unsigned char* lds, int tx) {
    for (int u = p.bx; u < 320; u += p.gx) {
        if (u < 64) scan_unit<32, 64>(p, l, 32 + (u >> 4), (u >> 3) & 1, (u & 7) * 32, lds, tx);
        else { const int v = u - 64; scan_unit<64, 32>(p, l, v >> 3, (v >> 2) & 1, (v & 3) * 64, lds, tx); }
    }
}

DI void seq_of_row(int r, int& base, int& key, int& Sk) {
    if (r < TC) { base = (r >> 8) * 256; key = r & 255; Sk = 256; }
    else if (r < T) { const int b = (r - TC) >> 10; base = TC + b * 1280; key = (r - TC) & 1023; Sk = 1280; }
    else { const int b = (r - T) >> 8; base = TC + b * 1280; key = 1024 + ((r - T) & 255); Sk = 1280; }
}
DI void phase_qk_finalize(const Params& p, int l, LAS unsigned char* lds, int tx) {
    const int tid = tx, lane = tid & 63, wave = tid >> 6, h = lane >> 3, j = lane & 7;
    const bf16_t* __restrict__ U = (const bf16_t*)(p.ws + WS_R1);
    const bf16_t* __restrict__ QRAW = (const bf16_t*)(p.ws + WS_R3);
    const bf16_t* __restrict__ KVRAW = (const bf16_t*)(p.ws + WS_KVRAW);
    bf16_t* __restrict__ Q = (bf16_t*)(p.ws + WS_R4);
    bf16_t* __restrict__ K = (bf16_t*)(p.ws + WS_K);
    bf16_t* __restrict__ VT = (bf16_t*)(p.ws + WS_VT);
    const float* qhg = p.in[I_QHG] + l * 96; const float* khg = p.in[I_KHG] + l * 96;
    LAS bf16_t* Vs = (LAS bf16_t*)lds;
    float qg[12], kg[12];
#pragma unroll
    for (int i = 0; i < 12; ++i) { qg[i] = qhg[j + 8 * i]; kg[i] = khg[j + 8 * i]; }
    const float invf = __builtin_amdgcn_exp2f(-1.6609640474436813f * (float)j);
    for (int unit = p.bx; unit < TKV / 64; unit += p.gx) {
        const bool mainrow = (unit * 64 < T);
        for (int hb = 0; hb < 2; ++hb) {
            const int rbase = unit * 64 + wave * 8 + hb * 4;
            float qv[4][12], kv[4][12]; u32x4 vw[4];
#pragma unroll
            for (int q = 0; q < 4; ++q) { const int r = rbase + q;
                if (mainrow) {
#pragma unroll
                    for (int i = 0; i < 12; ++i) qv[q][i] = bf2f(QRAW[(size_t)r * 768 + h * 96 + j + 8 * i]);
#pragma unroll
                    for (int i = 0; i < 4; ++i) kv[q][8 + i] = bf2f(U[(size_t)r * INWP + 1664 + j + 8 * i]);
                } else { const int rc = r - T, b_ = rc >> 8, s = rc & 255;
#pragma unroll
                    for (int i = 0; i < 12; ++i) qv[q][i] = 0.f;
#pragma unroll
                    for (int i = 0; i < 4; ++i) kv[q][8 + i] = p.in[I_CKR][((size_t)(b_ * 2 + l) * 256 + s) * 32 + j + 8 * i]; }
#pragma unroll
                for (int i = 0; i < 8; ++i) kv[q][i] = bf2f(KVRAW[(size_t)r * 1024 + h * 128 + j + 8 * i]);
                vw[q] = *(const u32x4*)(KVRAW + (size_t)r * 1024 + h * 128 + 64 + j * 8);
            }
#pragma unroll
            for (int q = 0; q < 4; ++q) { const int r = rbase + q;
                int base, key, Sk; seq_of_row(r, base, key, Sk);
                const bool rope = (r >= TC && r < T);
                float c0 = 1.f, s0 = 0.f, c1 = 1.f, s1 = 0.f;
                if (rope) { const int s = (r - TC) & 1023; const float a0 = (float)(s >> 6) * invf, a1 = (float)(s & 63) * invf; c0 = __cosf(a0); s0 = __sinf(a0); c1 = __cosf(a1); s1 = __sinf(a1); }
                float sq = 0.f, sk = 0.f;
#pragma unroll
                for (int i = 0; i < 12; ++i) { sq += qv[q][i] * qv[q][i]; sk += kv[q][i] * kv[q][i]; }
                sq += __shfl_xor(sq, 1); sk += __shfl_xor(sk, 1); sq += __shfl_xor(sq, 2); sk += __shfl_xor(sk, 2); sq += __shfl_xor(sq, 4); sk += __shfl_xor(sk, 4);
                const float iq = rsqrtf(sq * (1.0f / 96.0f) + EPS) * QSCALE, ik = rsqrtf(sk * (1.0f / 96.0f) + EPS);
#pragma unroll
                for (int i = 0; i < 12; ++i) { qv[q][i] = qv[q][i] * iq * qg[i]; kv[q][i] = kv[q][i] * ik * kg[i]; }
                if (rope) {
                    { const float x1 = qv[q][8], x2 = qv[q][9], x3 = qv[q][10], x4 = qv[q][11];
                      qv[q][8] = x1 * c0 - x2 * s0; qv[q][9] = x2 * c0 + x1 * s0; qv[q][10] = x3 * c1 - x4 * s1; qv[q][11] = x4 * c1 + x3 * s1; }
                    { const float x1 = kv[q][8], x2 = kv[q][9], x3 = kv[q][10], x4 = kv[q][11];
                      kv[q][8] = x1 * c0 - x2 * s0; kv[q][9] = x2 * c0 + x1 * s0; kv[q][10] = x3 * c1 - x4 * s1; kv[q][11] = x4 * c1 + x3 * s1; }
                }
                if (mainrow) {
#pragma unroll
                    for (int i = 0; i < 12; ++i) Q[((size_t)r * 8 + h) * 96 + j + 8 * i] = (bf16_t)(pack2(qv[q][i], 0.f) & 0xffffu);
                }
                bf16_t* kd = K + ((size_t)base * 8 + (size_t)h * Sk + key) * 96;
#pragma unroll
                for (int i = 0; i < 12; ++i) kd[j + 8 * i] = (bf16_t)(pack2(kv[q][i], 0.f) & 0xffffu);
                *(LAS u32x4*)(Vs + (wave * 8 + hb * 4 + q) * 520 + lane * 8) = vw[q];
            }
        }
        __syncthreads();
        {
            int base, key, Sk; seq_of_row(unit * 64, base, key, Sk);
            const int hh = tid >> 6, d = tid & 63;
            bf16_t* vd = VT + ((size_t)base * 8 + (size_t)hh * Sk) * 64 + (size_t)d * Sk + key;
#pragma unroll
            for (int q = 0; q < 8; ++q) { u32x4 w;
                w.x = (unsigned)Vs[(q * 8 + 0) * 520 + tid] | ((unsigned)Vs[(q * 8 + 1) * 520 + tid] << 16);
                w.y = (unsigned)Vs[(q * 8 + 2) * 520 + tid] | ((unsigned)Vs[(q * 8 + 3) * 520 + tid] << 16);
                w.z = (unsigned)Vs[(q * 8 + 4) * 520 + tid] | ((unsigned)Vs[(q * 8 + 5) * 520 + tid] << 16);
                w.w = (unsigned)Vs[(q * 8 + 6) * 520 + tid] | ((unsigned)Vs[(q * 8 + 7) * 520 + tid] << 16);
                *(u32x4*)(vd + q * 8) = w; }
        }
        __syncthreads();
    }
}

DI void attn_unit(const Params& p, int base, int Sk, int h, int qrow0, LAS unsigned char* lds, int tx, float negmB) {
    const int tid = tx, lane = tid & 63, wave = tid >> 6, grp = wave >> 2, wq = wave & 3, r32 = lane & 31, half = lane >> 5, gt = tid & 255;
    const bf16_t* __restrict__ Q = (const bf16_t*)(p.ws + WS_R4);
    const bf16_t* __restrict__ Kg = (const bf16_t*)(p.ws + WS_K) + ((size_t)base * 8 + (size_t)h * Sk) * 96;
    const bf16_t* __restrict__ Vg = (const bf16_t*)(p.ws + WS_VT) + ((size_t)base * 8 + (size_t)h * Sk) * 64;
    bf16_t* __restrict__ O = (bf16_t*)(p.ws + WS_R3);
    LAS unsigned char* Ks = lds + grp * 22528;
    LAS unsigned char* Vs = Ks + 13312;
    const int qrow = qrow0 + wq * 32 + r32;
    bf16x8 Qf[6];
#pragma unroll
    for (int kk = 0; kk < 6; ++kk) Qf[kk] = *(const bf16x8*)(Q + ((size_t)qrow * 8 + h) * 96 + 16 * kk + 8 * half);
    int kr[3], kcc[3], vd[2], vcc[2];
#pragma unroll
    for (int i = 0; i < 3; ++i) { const int c = gt + 256 * i; kr[i] = c / 12; kcc[i] = c % 12; }
#pragma unroll
    for (int i = 0; i < 2; ++i) { const int c = gt + 256 * i; vd[i] = c >> 3; vcc[i] = c & 7; }
    f32x16 o0, o1;
#pragma unroll
    for (int i = 0; i < 16; ++i) { o0[i] = 0.f; o1[i] = 0.f; }
    float lsum = 0.f;
    const int nit = Sk >> 7;
    u32x4 kreg[3], vreg[2];
    {   const bf16_t* kn = Kg + (size_t)grp * 64 * 96;
#pragma unroll
        for (int i = 0; i < 3; ++i) kreg[i] = *(const u32x4*)(kn + (size_t)kr[i] * 96 + kcc[i] * 8);
#pragma unroll
        for (int i = 0; i < 2; ++i) vreg[i] = *(const u32x4*)(Vg + (size_t)vd[i] * Sk + grp * 64 + vcc[i] * 8); }
    for (int it = 0; it < nit; ++it) {
        __syncthreads();
#pragma unroll
        for (int i = 0; i < 3; ++i) *(LAS u32x4*)(Ks + kr[i] * 208 + kcc[i] * 16) = kreg[i];
#pragma unroll
        for (int i = 0; i < 2; ++i) *(LAS u32x4*)(Vs + vd[i] * 144 + vcc[i] * 16) = vreg[i];
        __syncthreads();
        if (it + 1 < nit) {
            const int kt = 2 * (it + 1) + grp;
            const bf16_t* kn = Kg + (size_t)kt * 64 * 96;
#pragma unroll
            for (int i = 0; i < 3; ++i) kreg[i] = *(const u32x4*)(kn + (size_t)kr[i] * 96 + kcc[i] * 8);
#pragma unroll
            for (int i = 0; i < 2; ++i) vreg[i] = *(const u32x4*)(Vg + (size_t)vd[i] * Sk + kt * 64 + vcc[i] * 8);
        }
        f32x16 s0, s1;
#pragma unroll
        for (int i = 0; i < 16; ++i) { s0[i] = negmB; s1[i] = negmB; }
#pragma unroll
        for (int kk = 0; kk < 6; ++kk) {
            const bf16x8 a0 = *(const LAS bf16x8*)(Ks + r32 * 208 + (16 * kk + 8 * half) * 2);
            const bf16x8 a1 = *(const LAS bf16x8*)(Ks + (32 + r32) * 208 + (16 * kk + 8 * half) * 2);
            s0 = MFMA32(a0, Qf[kk], s0); s1 = MFMA32(a1, Qf[kk], s1);
        }
        float ps = 0.f;
#pragma unroll
        for (int i = 0; i < 16; ++i) { s0[i] = __builtin_amdgcn_exp2f(s0[i]); s1[i] = __builtin_amdgcn_exp2f(s1[i]); ps += s0[i] + s1[i]; }
        lsum += ps;
#pragma unroll
        for (int kt2 = 0; kt2 < 2; ++kt2) {
#pragma unroll
            for (int s = 0; s < 2; ++s) {
                u32x4 pw;
                if (kt2 == 0) { pw.x = pack2(s0[8 * s], s0[8 * s + 1]); pw.y = pack2(s0[8 * s + 2], s0[8 * s + 3]); pw.z = pack2(s0[8 * s + 4], s0[8 * s + 5]); pw.w = pack2(s0[8 * s + 6], s0[8 * s + 7]); }
                else          { pw.x = pack2(s1[8 * s], s1[8 * s + 1]); pw.y = pack2(s1[8 * s + 2], s1[8 * s + 3]); pw.z = pack2(s1[8 * s + 4], s1[8 * s + 5]); pw.w = pack2(s1[8 * s + 6], s1[8 * s + 7]); }
                const bf16x8 pb = __builtin_bit_cast(bf16x8, pw);
                const int koff = (32 * kt2 + 16 * s + 4 * half) * 2;
                const s16x4 v0lo = *(const LAS s16x4*)(Vs + r32 * 144 + koff), v0hi = *(const LAS s16x4*)(Vs + r32 * 144 + koff + 16);
                const s16x4 v1lo = *(const LAS s16x4*)(Vs + (32 + r32) * 144 + koff), v1hi = *(const LAS s16x4*)(Vs + (32 + r32) * 144 + koff + 16);
                const bf16x8 va0 = __builtin_shufflevector(v0lo, v0hi, 0, 1, 2, 3, 4, 5, 6, 7), va1 = __builtin_shufflevector(v1lo, v1hi, 0, 1, 2, 3, 4, 5, 6, 7);
                o0 = MFMA32(va0, pb, o0); o1 = MFMA32(va1, pb, o1);
            }
        }
    }
    lsum += __shfl_xor(lsum, 32);
    LAS float* cb = (LAS float*)lds + (size_t)(wq * 34) * 64 + lane;
    __syncthreads();
    if (grp == 1) {
#pragma unroll
        for (int i = 0; i < 16; ++i) { cb[i * 64] = o0[i]; cb[(16 + i) * 64] = o1[i]; }
        cb[33 * 64] = lsum;
    }
    __syncthreads();
    if (grp == 0) {
        const float inv = 1.0f / (lsum + cb[33 * 64]);
        const float w0 = inv, w1 = inv;
        bf16_t* orow = O + (size_t)qrow * 512 + h * 64 + 4 * half;
#pragma unroll
        for (int g = 0; g < 4; ++g) {
            f32x4 a = {o0[4 * g] * w0 + cb[(4 * g) * 64] * w1, o0[4 * g + 1] * w0 + cb[(4 * g + 1) * 64] * w1, o0[4 * g + 2] * w0 + cb[(4 * g + 2) * 64] * w1, o0[4 * g + 3] * w0 + cb[(4 * g + 3) * 64] * w1};
            f32x4 b = {o1[4 * g] * w0 + cb[(16 + 4 * g) * 64] * w1, o1[4 * g + 1] * w0 + cb[(16 + 4 * g + 1) * 64] * w1, o1[4 * g + 2] * w0 + cb[(16 + 4 * g + 2) * 64] * w1, o1[4 * g + 3] * w0 + cb[(16 + 4 * g + 3) * 64] * w1};
            u32x2 wa_, wb_; wa_.x = pack2(a[0], a[1]); wa_.y = pack2(a[2], a[3]); wb_.x = pack2(b[0], b[1]); wb_.y = pack2(b[2], b[3]);
            *(u32x2*)(orow + 8 * g) = wa_; *(u32x2*)(orow + 32 + 8 * g) = wb_;
        }
    }
}
DI void attn_dispatch(const Params& p, int u, LAS unsigned char* lds, int tx, float negmB) {
    if (u < 256) { const int b = u >> 6, h = (u >> 3) & 7, qb = u & 7; attn_unit(p, TC + b * 1280, 1280, h, TC + b * 1024 + qb * 128, lds, tx, negmB); }
    else { const int v = u - 256, sg = v >> 4, h = (v >> 1) & 7, hf = v & 1; attn_unit(p, sg * 256, 256, h, sg * 256 + hf * 128, lds, tx, negmB); }
}
DI void phase_attn(const Params& p, int l, LAS unsigned char* lds, int tx) {
    const int G = p.gx, b = p.bx;
    float gq = 0.f, gk = 0.f;
    for (int i = 0; i < 96; ++i) { gq = fmaxf(gq, fabsf(p.in[I_QHG][l * 96 + i])); gk = fmaxf(gk, fabsf(p.in[I_KHG][l * 96 + i])); }
    const float negmB = -fminf((96.0f * QSCALE) * gq * gk * 1.01f, 64.0f);
    if (G == 256) { attn_dispatch(p, b, lds, tx, negmB); attn_dispatch(p, 256 + 2 * b, lds, tx, negmB); attn_dispatch(p, 256 + 2 * b + 1, lds, tx, negmB); }
    else { for (int u = b; u < 768; u += G) attn_dispatch(p, u, lds, tx, negmB); }
}

DI float gelu_tanh(float x) { const float u = 0.7978845608028654f * (x + 0.044715f * x * x * x); const float e = __expf(2.0f * u); const float t = 1.0f - 2.0f / (e + 1.0f); return 0.5f * x * (1.0f + t); }
struct MixRow { u32x2 cg[3], hh[3], bg, yb, p0, p1; f32x4 hf, hb; };
DI MixRow mix_load(const bf16_t* __restrict__ U, const float* __restrict__ HF, const float* __restrict__ HB, const bf16_t* __restrict__ O, int r, int c) {
    MixRow m;
    const int s = (r < TC) ? (r & 255) : ((r - TC) & 1023), S = (r < TC) ? 256 : 1024;
#pragma unroll
    for (int k = 0; k < 3; ++k) { const int sk = s + k - 1; const bool ok = (sk >= 0 && sk < S); const bf16_t* u = U + (size_t)(r + (ok ? k - 1 : 0)) * INWP;
        const u32x2 z = {0u, 0u}; const u32x2 a = *(const u32x2*)(u + 256 + c), b = *(const u32x2*)(u + 512 + c); m.cg[k] = ok ? a : z; m.hh[k] = ok ? b : z; }
    m.bg = *(const u32x2*)(U + (size_t)r * INWP + c); m.yb = *(const u32x2*)(U + (size_t)r * INWP + 1024 + c);
    m.hf = *(const f32x4*)(HF + (size_t)r * 256 + c); m.hb = *(const f32x4*)(HB + (size_t)r * 256 + c);
    m.p0 = *(const u32x2*)(O + (size_t)r * 512 + c); m.p1 = *(const u32x2*)(O + (size_t)r * 512 + 256 + c);
    return m;
}
DI void mix_store(const MixRow& m, bf16_t* __restrict__ Y, int r, int c, const f32x4 (&wv)[3], const f32x4& cbv, const f32x4& gcv, const f32x4& glv, const f32x4& gm0, const f32x4& gm1) {
    const f32x4 o0 = {bflo(m.p0.x), bfhi(m.p0.x), bflo(m.p0.y), bfhi(m.p0.y)}, o1 = {bflo(m.p1.x), bfhi(m.p1.x), bflo(m.p1.y), bfhi(m.p1.y)};
    f32x4 acc = cbv;
#pragma unroll
    for (int k = 0; k < 3; ++k) { acc[0] += wv[k][0] * (bflo(m.cg[k].x) * bflo(m.hh[k].x)); acc[1] += wv[k][1] * (bfhi(m.cg[k].x) * bfhi(m.hh[k].x));
        acc[2] += wv[k][2] * (bflo(m.cg[k].y) * bflo(m.hh[k].y)); acc[3] += wv[k][3] * (bfhi(m.cg[k].y) * bfhi(m.hh[k].y)); }
    const f32x4 y1 = {bflo(m.bg.x) * acc[0], bfhi(m.bg.x) * acc[1], bflo(m.bg.y) * acc[2], bfhi(m.bg.y) * acc[3]};
    const f32x4 y2 = {(m.hf[0] + m.hb[0]) * gelu_tanh(bflo(m.yb.x)), (m.hf[1] + m.hb[1]) * gelu_tanh(bfhi(m.yb.x)), (m.hf[2] + m.hb[2]) * gelu_tanh(bflo(m.yb.y)), (m.hf[3] + m.hb[3]) * gelu_tanh(bfhi(m.yb.y))};
    float s1 = y1[0] * y1[0] + y1[1] * y1[1] + y1[2] * y1[2] + y1[3] * y1[3];
    float s2 = y2[0] * y2[0] + y2[1] * y2[1] + y2[2] * y2[2] + y2[3] * y2[3];
    float s3 = o0[0] * o0[0] + o0[1] * o0[1] + o0[2] * o0[2] + o0[3] * o0[3] + o1[0] * o1[0] + o1[1] * o1[1] + o1[2] * o1[2] + o1[3] * o1[3];
#pragma unroll
    for (int o = 32; o >= 1; o >>= 1) { s1 += __shfl_xor(s1, o); s2 += __shfl_xor(s2, o); s3 += __shfl_xor(s3, o); }
    const float i1 = rsqrtf(s1 * (1.0f / 256.0f) + EPS), i2 = rsqrtf(s2 * (1.0f / 256.0f) + EPS), i3 = rsqrtf(s3 * (1.0f / 512.0f) + EPS);
    u32x2 o;
    o.x = pack2(y1[0] * i1 * gcv[0], y1[1] * i1 * gcv[1]); o.y = pack2(y1[2] * i1 * gcv[2], y1[3] * i1 * gcv[3]); *(u32x2*)(Y + (size_t)r * D + c) = o;
    o.x = pack2(y2[0] * i2 * glv[0], y2[1] * i2 * glv[1]); o.y = pack2(y2[2] * i2 * glv[2], y2[3] * i2 * glv[3]); *(u32x2*)(Y + (size_t)r * D + 256 + c) = o;
    o.x = pack2(o0[0] * i3 * gm0[0], o0[1] * i3 * gm0[1]); o.y = pack2(o0[2] * i3 * gm0[2], o0[3] * i3 * gm0[3]); *(u32x2*)(Y + (size_t)r * D + 512 + c) = o;
    o.x = pack2(o1[0] * i3 * gm1[0], o1[1] * i3 * gm1[1]); o.y = pack2(o1[2] * i3 * gm1[2], o1[3] * i3 * gm1[3]); *(u32x2*)(Y + (size_t)r * D + 768 + c) = o;
}
DI void phase_mix_finalize(const Params& p, int l, int tx, int rlo = 0, int rhi = T) {
    const int lane = tx & 63, wave = tx >> 6, c = 4 * lane;
    const bf16_t* __restrict__ U = (const bf16_t*)(p.ws + WS_R1);
    const float* __restrict__ HF = (const float*)(p.ws + WS_HF); const float* __restrict__ HB = HF + (size_t)T * 256;
    const bf16_t* __restrict__ O = (const bf16_t*)(p.ws + WS_R3);
    bf16_t* __restrict__ Y = (bf16_t*)(p.ws + WS_R2);
    const float* cw = p.in[I_CONVW] + l * 3 * 256;
    f32x4 wv[3];
#pragma unroll
    for (int k = 0; k < 3; ++k) wv[k] = *(const f32x4*)(cw + k * 256 + c);
    const f32x4 cbv = *(const f32x4*)(p.in[I_CONVB] + l * 256 + c), gcv = *(const f32x4*)(p.in[I_GNC] + l * 256 + c), glv = *(const f32x4*)(p.in[I_GNL] + l * 256 + c);
    const f32x4 gm0 = *(const f32x4*)(p.in[I_GNM] + l * 512 + c), gm1 = *(const f32x4*)(p.in[I_GNM] + l * 512 + 256 + c);
    for (int rb = rlo + (p.bx * 8 + wave) * 2; rb < rhi; rb += p.gx * 8 * 2) {
        const MixRow m0 = mix_load(U, HF, HB, O, rb, c), m1 = mix_load(U, HF, HB, O, rb + 1, c);
        mix_store(m0, Y, rb, c, wv, cbv, gcv, glv, gm0, gm1);
        mix_store(m1, Y, rb + 1, c, wv, cbv, gcv, glv, gm0, gm1);
    }
}

#define XB_TMO      128
#define XB_XCNT(j)  (256  + 64 * (j))
#define XB_XSUB(j)  (1280 + 64 * (j))
#define XB_XGEN(j)  (2304 + 64 * (j))
#define XB_TOP      3328
#define XB_TOPGEN   3392
#define XCD_BAR_WORDS 3456
#define XB_SPIN_CAP (1u << 18)
__device__ __forceinline__ unsigned xb_ld(unsigned* p)              { return __hip_atomic_load(p, __ATOMIC_RELAXED, __HIP_MEMORY_SCOPE_AGENT); }
__device__ __forceinline__ unsigned xb_add(unsigned* p, unsigned v) { return __hip_atomic_fetch_add(p, v, __ATOMIC_RELAXED, __HIP_MEMORY_SCOPE_AGENT); }
__device__ __forceinline__ unsigned xb_xcc_id() { return (unsigned)__builtin_amdgcn_s_getreg((3 << 11) | 20) & 0xFu; }
#define XB_SPIN(cond, bar) do { unsigned _sp = 0; while (cond) { __builtin_amdgcn_s_sleep(1); \
    if ((++_sp & 255u) == 0u) { if (xb_ld(&(bar)[XB_TMO])) break; if (_sp > XB_SPIN_CAP) { atomicAdd(&(bar)[XB_TMO], 1u); break; } } } } while (0)

struct XcdBarrier {
    unsigned* bar; unsigned x;
    volatile LAS unsigned* st;
};

__device__ __forceinline__ XcdBarrier xcd_barrier_post(unsigned* bar, volatile LAS unsigned* st) {
    XcdBarrier b; b.bar = bar; b.x = xb_xcc_id(); b.st = st;
    if (threadIdx.x == 0) (void)xb_add(&bar[XB_XCNT(b.x)], 1u);
    return b;
}
__device__ __forceinline__ void xcd_barrier_complete(unsigned* bar, unsigned x, unsigned& nloc, unsigned& nx) {
    const unsigned G = gridDim.x * gridDim.y * gridDim.z;
    unsigned sum, cnt, mine, sp = 0u;
    for (;;) {
        sum = 0u; cnt = 0u; mine = 0u;
#pragma unroll
        for (unsigned j = 0; j < 16; ++j) { const unsigned c = xb_ld(&bar[XB_XCNT(j)]); sum += c; cnt += (c > 0u) ? 1u : 0u; mine = (j == x) ? c : mine; }
        if (sum == G) break;
        __builtin_amdgcn_s_sleep(1);
        if ((++sp & 255u) == 0u) { if (xb_ld(&bar[XB_TMO])) break; if (sp > XB_SPIN_CAP) { atomicAdd(&bar[XB_TMO], 1u); break; } }
    }
    nloc = mine > 0u ? mine : 1u; nx = cnt > 0u ? cnt : 1u;
}

__device__ __forceinline__ void xcd_barrier(const XcdBarrier& b) {
    asm volatile("s_waitcnt vmcnt(0)" ::: "memory");
    __syncthreads();
    if (threadIdx.x == 0) {
        unsigned* bar = b.bar;
        __builtin_amdgcn_s_waitcnt(0);
        unsigned nloc = b.st[0], nx = b.st[1];
        if (nloc == 0u) { xcd_barrier_complete(bar, b.x, nloc, nx); b.st[0] = nloc; b.st[1] = nx; }
        const unsigned old = xb_add(&bar[XB_XSUB(b.x)], 1u);
        const unsigned gen = old / nloc;
        if (old + 1u == (gen + 1u) * nloc) {
            __builtin_amdgcn_fence(__ATOMIC_RELEASE, "agent");
            asm volatile("s_waitcnt vmcnt(0)" ::: "memory");
            const unsigned og = xb_add(&bar[XB_TOP], 1u);
            const unsigned tg = og / nx;
            if (og + 1u == (tg + 1u) * nx) xb_add(&bar[XB_TOPGEN], 1u);
            else XB_SPIN(xb_ld(&bar[XB_TOPGEN]) == tg, bar);
            __builtin_amdgcn_fence(__ATOMIC_ACQUIRE, "agent");
            xb_add(&bar[XB_XGEN(b.x)], 1u);
            asm volatile("s_waitcnt vmcnt(0)" ::: "memory");
        } else {
            XB_SPIN(xb_ld(&bar[XB_XGEN(b.x)]) == gen, bar);
            __builtin_amdgcn_fence(__ATOMIC_ACQUIRE, "agent");
            asm volatile("s_waitcnt vmcnt(0)" ::: "memory");
        }
    }
    __syncthreads();
}

struct EpiResGate {
    static constexpr bool PERM = true, AFTER_DRAIN = false;
    const float* xa; const float* xb; float* out; const float* gate;
    __device__ __forceinline__ void operator()(const pg8::f32x4 (&acc)[2][2][4][2], const pg8::Unit& u, int wr, int wc, int fr, int fq) const {
        const int row0 = u.pm * 256 + wr * 64 + fr, col0 = u.pn * 256 + wc * 32 + 8 * fq;
        const int ci = (u.pm < 32) ? 0 : 1 + ((u.pm - 32) >> 2);
        const float* __restrict__ xin = (u.pm < 32) ? xa : (xb - (size_t)TC * D);
        float* __restrict__ o = out;
        pg8::f32x4 gv[2][2];
#pragma unroll
        for (int bj = 0; bj < 2; ++bj)
#pragma unroll
            for (int n = 0; n < 2; ++n) gv[bj][n] = *(const pg8::f32x4*)(gate + ci * 6144 + col0 + bj * 128 + 4 * n);
#pragma unroll
        for (int ai = 0; ai < 2; ++ai) {
            pg8::f32x4 xv[4][2][2];
#pragma unroll
            for (int m = 0; m < 4; ++m) { const size_t off = (size_t)(row0 + ai * 128 + m * 16) * D + col0;
#pragma unroll
                for (int bj = 0; bj < 2; ++bj)
#pragma unroll
                    for (int n = 0; n < 2; ++n) xv[m][bj][n] = *(const pg8::f32x4*)(xin + off + bj * 128 + 4 * n); }
            asm volatile("" ::: "memory");
#pragma unroll
            for (int m = 0; m < 4; ++m) { const size_t off = (size_t)(row0 + ai * 128 + m * 16) * D + col0;
#pragma unroll
                for (int bj = 0; bj < 2; ++bj)
#pragma unroll
                    for (int n = 0; n < 2; ++n) *(pg8::f32x4*)(o + off + bj * 128 + 4 * n) = xv[m][bj][n] + gv[bj][n] * acc[ai][bj][m][n]; }
            asm volatile("" ::: "memory");
        }
    }
};
struct EpiSwiGLU {
    static constexpr bool PERM = false, AFTER_DRAIN = false;
    bf16_t* G;
    __device__ __forceinline__ void operator()(const pg8::f32x4 (&acc)[2][2][4][2], const pg8::Unit& u, int wr, int wc, int fr, int fq) const {
        const int row0 = u.pm * 256 + wr * 64 + fr, colg0 = u.pn * 128 + wc * 16 + 4 * fq;
#pragma unroll
        for (int ai = 0; ai < 2; ++ai)
#pragma unroll
            for (int m = 0; m < 4; ++m) { bf16_t* rowp = G + (size_t)(row0 + ai * 128 + m * 16) * FF + colg0;
#pragma unroll
                for (int bj = 0; bj < 2; ++bj) { const pg8::f32x4 g = acc[ai][bj][m][0], up = acc[ai][bj][m][1];
                    float y[4];
#pragma unroll
                    for (int i = 0; i < 4; ++i) y[i] = g[i] / (1.0f + __expf(-g[i])) * up[i];
                    u32x2 w; w.x = pack2(y[0], y[1]); w.y = pack2(y[2], y[3]);
                    *(u32x2*)(rowp + bj * 64) = w; } }
    }
};

DI int cond_of_pm(int pm) { return (pm < 32) ? 0 : 1 + ((pm - 32) >> 2); }
struct EpiIn {
    static constexpr bool PERM = true, AFTER_DRAIN = false;
    bf16_t* O; const float* rs; const float* bias;
    __device__ __forceinline__ void operator()(const pg8::f32x4 (&acc)[2][2][4][2], const pg8::Unit& u, int wr, int wc, int fr, int fq) const {
        const int row0 = u.pm * 256 + wr * 64 + fr, col0 = u.pn * 256 + wc * 32 + 8 * fq;
        const float* bp = bias + cond_of_pm(u.pm) * INWP + col0;
        pg8::f32x4 bv[2][2]; float inv[2][4];
#pragma unroll
        for (int bj = 0; bj < 2; ++bj)
#pragma unroll
            for (int n = 0; n < 2; ++n) bv[bj][n] = *(const pg8::f32x4*)(bp + bj * 128 + 4 * n);
#pragma unroll
        for (int ai = 0; ai < 2; ++ai)
#pragma unroll
            for (int m = 0; m < 4; ++m) inv[ai][m] = rs[row0 + ai * 128 + m * 16];
#pragma unroll
        for (int ai = 0; ai < 2; ++ai)
#pragma unroll
            for (int m = 0; m < 4; ++m) { const float iv = rsqrtf(inv[ai][m] * (1.0f / 1024.0f) + EPS); bf16_t* rowp = O + (size_t)(row0 + ai * 128 + m * 16) * INWP + col0;
#pragma unroll
                for (int bj = 0; bj < 2; ++bj) { const pg8::f32x4 v0 = acc[ai][bj][m][0] * iv + bv[bj][0], v1 = acc[ai][bj][m][1] * iv + bv[bj][1];
                    u32x4 w; w.x = pack2(v0[0], v0[1]); w.y = pack2(v0[2], v0[3]); w.z = pack2(v1[0], v1[1]); w.w = pack2(v1[2], v1[3]);
                    *(u32x4*)(rowp + bj * 128) = w; } }
    }
};
struct EpiSwiGLU2 {
    static constexpr bool PERM = true, AFTER_DRAIN = false;
    bf16_t* G; const float* rs; const float* bias;
    __device__ __forceinline__ void operator()(const pg8::f32x4 (&acc)[2][2][4][2], const pg8::Unit& u, int wr, int wc, int fr, int fq) const {
        const int row0 = u.pm * 256 + wr * 64 + fr, colg0 = u.pn * 128 + wc * 32 + 8 * fq;
        const float* bp = bias + cond_of_pm(u.pm) * 2 * FF + u.pn * 256 + wc * 32 + 8 * fq;
        pg8::f32x4 bv[2][2]; float inv[2][4];
#pragma unroll
        for (int bj = 0; bj < 2; ++bj)
#pragma unroll
            for (int n = 0; n < 2; ++n) bv[bj][n] = *(const pg8::f32x4*)(bp + bj * 128 + 4 * n);
#pragma unroll
        for (int ai = 0; ai < 2; ++ai)
#pragma unroll
            for (int m = 0; m < 4; ++m) inv[ai][m] = rs[row0 + ai * 128 + m * 16];
#pragma unroll
        for (int ai = 0; ai < 2; ++ai)
#pragma unroll
            for (int m = 0; m < 4; ++m) { const float iv = rsqrtf(inv[ai][m] * (1.0f / 1024.0f) + EPS);
                float y[8];
#pragma unroll
                for (int n = 0; n < 2; ++n) { const pg8::f32x4 g = acc[ai][0][m][n] * iv + bv[0][n], up = acc[ai][1][m][n] * iv + bv[1][n];
#pragma unroll
                    for (int i = 0; i < 4; ++i) y[4 * n + i] = g[i] * __builtin_amdgcn_rcpf(1.0f + __builtin_amdgcn_exp2f(-1.4426950408889634f * g[i])) * up[i]; }
                u32x4 w; w.x = pack2(y[0], y[1]); w.y = pack2(y[2], y[3]); w.z = pack2(y[4], y[5]); w.w = pack2(y[6], y[7]);
                *(u32x4*)(G + (size_t)(row0 + ai * 128 + m * 16) * FF + colg0) = w; }
    }
};
struct EpiResGateN {
    static constexpr bool PERM = true, AFTER_DRAIN = false;
    const float* xa; const float* xb; float* out; const float* gate; bf16_t* An; const float* wtab; float* rs;
    __device__ __forceinline__ void operator()(const pg8::f32x4 (&acc)[2][2][4][2], const pg8::Unit& u, int wr, int wc, int fr, int fq) const {
        const int row0 = u.pm * 256 + wr * 64 + fr, col0 = u.pn * 256 + wc * 32 + 8 * fq;
        const int ci = cond_of_pm(u.pm);
        const float* __restrict__ xin = (u.pm < 32) ? xa : (xb - (size_t)TC * D);
        float* __restrict__ o = out; bf16_t* __restrict__ an = An;
        pg8::f32x4 gv[2][2], wv[2][2];
#pragma unroll
        for (int bj = 0; bj < 2; ++bj)
#pragma unroll
            for (int n = 0; n < 2; ++n) { gv[bj][n] = *(const pg8::f32x4*)(gate + ci * 6144 + col0 + bj * 128 + 4 * n); wv[bj][n] = *(const pg8::f32x4*)(wtab + ci * 1024 + col0 + bj * 128 + 4 * n); }
#pragma unroll
        for (int ai = 0; ai < 2; ++ai)
#pragma unroll
            for (int mh = 0; mh < 2; ++mh) {
                pg8::f32x4 xv[2][2][2];
#pragma unroll
                for (int mm = 0; mm < 2; ++mm) { const size_t off = (size_t)(row0 + ai * 128 + (2 * mh + mm) * 16) * D + col0;
#pragma unroll
                    for (int bj = 0; bj < 2; ++bj)
#pragma unroll
                        for (int n = 0; n < 2; ++n) xv[mm][bj][n] = *(const pg8::f32x4*)(xin + off + bj * 128 + 4 * n); }
                asm volatile("" ::: "memory");
#pragma unroll
                for (int mm = 0; mm < 2; ++mm) { const int m = 2 * mh + mm; const int row = row0 + ai * 128 + m * 16; const size_t off = (size_t)row * D + col0;
                    float ss = 0.f;
#pragma unroll
                    for (int bj = 0; bj < 2; ++bj) { u32x4 w;
#pragma unroll
                        for (int n = 0; n < 2; ++n) { const pg8::f32x4 x1 = xv[mm][bj][n] + gv[bj][n] * acc[ai][bj][m][n];
                            *(pg8::f32x4*)(o + off + bj * 128 + 4 * n) = x1;
                            ss += x1[0] * x1[0] + x1[1] * x1[1] + x1[2] * x1[2] + x1[3] * x1[3];
                            const pg8::f32x4 y = x1 * wv[bj][n];
                            if (n == 0) { w.x = pack2(y[0], y[1]); w.y = pack2(y[2], y[3]); } else { w.z = pack2(y[0], y[1]); w.w = pack2(y[2], y[3]); } }
                        *(u32x4*)(an + off + bj * 128) = w; }
                    ss += __shfl_xor(ss, 16); ss += __shfl_xor(ss, 32);
                    if (fq == 0) atomicAdd(rs + row, ss); }
                asm volatile("" ::: "memory");
            }
    }
};

struct EpiNull { static constexpr bool PERM = true, AFTER_DRAIN = false; float* sink;
    __device__ __forceinline__ void operator()(const pg8::f32x4 (&acc)[2][2][4][2], const pg8::Unit& u, int wr, int wc, int fr, int fq) const { if (acc[0][0][0][0][0] == 1.2345e37f) sink[0] = 1.f; } };
struct QKVOrder {
    int G, c;
    __device__ __forceinline__ bool next(int i, pg8::Unit& u) const {
        const int L = i * G + c;
        if (L < 144) { u.pm = L / 3; u.pn = L % 3; return true; }
        const int L2 = L - 144; if (L2 >= 208) return false;
        u.pm = 48 + (L2 >> 2); u.pn = 3 + (L2 & 3); return true;
    }
    __device__ __forceinline__ void a_ready(const pg8::Unit&) const {}
    __device__ __forceinline__ void done(const pg8::Unit&) const {}
};
struct EpiQKV {
    static constexpr bool PERM = true, AFTER_DRAIN = false;
    bf16_t* QR; bf16_t* KVR;
    __device__ __forceinline__ void operator()(const pg8::f32x4 (&acc)[2][2][4][2], const pg8::Unit& u, int wr, int wc, int fr, int fq) const {
        const bool isq = u.pn < 3;
        const int ldc = isq ? 768 : 1024;
        bf16_t* base = isq ? QR + (size_t)(u.pm * 256) * 768 + u.pn * 256 : KVR + (size_t)((u.pm - 48) * 256) * 1024 + (u.pn - 3) * 256;
        const int rowl = wr * 64 + fr, col0 = wc * 32 + 8 * fq;
#pragma unroll
        for (int ai = 0; ai < 2; ++ai)
#pragma unroll
            for (int m = 0; m < 4; ++m) { bf16_t* rowp = base + (size_t)(rowl + ai * 128 + m * 16) * ldc + col0;
#pragma unroll
                for (int bj = 0; bj < 2; ++bj) { const pg8::f32x4 v0 = acc[ai][bj][m][0], v1 = acc[ai][bj][m][1];
                    u32x4 w; w.x = pack2(v0[0], v0[1]); w.y = pack2(v0[2], v0[3]); w.z = pack2(v1[0], v1[1]); w.w = pack2(v1[2], v1[3]);
                    *(u32x4*)(rowp + bj * 128) = w; } }
    }
};
template <class Epi> DI void run_gemm(const Params& p, LAS unsigned char* lds, const bf16_t* A, const bf16_t* Bt, int M, int N, int K, const Epi& E, int tx, bool rev = false) {
    pg8::Gemm g{A, Bt, M, N, K}; pg8::StaticOrder S; S.init(M, N, p.gx, rev ? p.gx - 1 - p.bx : p.bx);
    pg8::gemm_phase<Epi, pg8::StaticOrder, false>(lds, g, S, E, nullptr, tx);
}

__global__ void __launch_bounds__(NT, 2) fwd_megakernel(KParams pk) {
    extern __shared__ __attribute__((aligned(16))) unsigned char shm[];
    LAS unsigned char* lds = (LAS unsigned char*)shm;
    cg::grid_group grid = cg::this_grid();
    const int wv64 = __builtin_amdgcn_readfirstlane((int)threadIdx.x >> 6) * 64;
    if (threadIdx.x < 4) ((LAS unsigned*)(lds + LDS_STAGE))[threadIdx.x] = 0u;
    __syncthreads();
    XcdBarrier bar = xcd_barrier_post((unsigned*)(pk.ws + WS_BAR), (volatile LAS unsigned*)(lds + LDS_STAGE));
    if (pk.ph_lo < 0) grid.sync();
    for (int pass = (PREFIX > 0 ? 0 : 1); pass < 2; ++pass) {
    const int ph_end = (pass == 0) ? PREFIX : pk.ph_hi;
    for (int ph = pk.ph_lo; ph < ph_end; ++ph) {
        unsigned zl = 0u; size_t zo = 0; asm volatile("" : "+v"(zl), "+s"(zo));
        int tx = wv64 + (int)__builtin_amdgcn_mbcnt_hi(~0u, __builtin_amdgcn_mbcnt_lo(~0u, zl));
        Params p; p.out = pk.out + zo; p.ws = pk.ws + zo; { int bx_ = (int)blockIdx.x, gx_ = (int)gridDim.x; asm volatile("" : "+s"(bx_), "+s"(gx_)); p.bx = bx_; p.gx = gx_; }
#pragma unroll
        for (int i = 0; i < 34; ++i) p.in[i] = pk.in[i] + zo;
        unsigned char* ws = p.ws;
        if (ph == 0) { phase_zero_rs(p, tx); REP(0, phase_mod(p, lds, tx, 0, p.bx, p.gx)); REP(1, phase_convert(p, 0, lds, tx, p.gx - 1 - p.bx, p.gx, 0, 8 * 28)); }
        else {
            const int l = (ph <= 10) ? 0 : 1, idx = (l == 0) ? ph - 1 : ph - 11;
            const int k = (l == 0) ? (idx < 8 ? idx : idx + 1) : (idx < 7 ? idx + 1 : idx + 2);
            const float* modl = (const float*)(ws + WS_MOD) + (size_t)l * 5 * 6144;
            const unsigned char* wt = ws + (l ? WS_WT2 : 0);
            const float* xa = (l == 0) ? p.in[I_XP] : p.out; const float* xb = (l == 0) ? p.in[I_XS] : p.out + (size_t)TC * D;
            float* rsb = (float*)(ws + WS_RS); const float* wtab = (const float*)(ws + WS_WTAB);
            switch (k) {
            case 0: REP(2, phase_prep0(p, xa, xb, p.in[I_N1G], modl, 1024, tx)); phase_tables(p, tx, 0); phase_bias(p, 0, p.bx, p.gx, tx, 1); break;
            case 1: { EpiIn E{(bf16_t*)(ws + WS_R1), rsb + (size_t)(2 * l) * T, (const float*)(ws + WS_BIN) + (size_t)l * 5 * INWP}; REP(10, run_gemm(p, lds, (const bf16_t*)(ws + WS_R2), (const bf16_t*)(wt + WS_WT_IN), T, INWP, 1024, E, tx));
                      if (l == 0) { const bool big = p.gx > 160;
                        if (!big || p.bx >= 80) { FRESH_TX(txc); phase_convert(p, 0, lds, txc, big ? p.bx - 80 : p.bx, big ? p.gx - 80 : p.gx, 8 * 28); } } } break;
            case 2: if (!(pass == 0 && PFLAG == 2)) { REP(3, phase_post_in(p, l, tx)); } if (!(pass == 0 && PFLAG == 1)) { REP(9, phase_gates(p, l, lds, tx)); }
                    if (l == 0) { FRESH_TX(txb2); phase_bias(p, 0, p.bx, p.gx, txb2, 2); } break;
            case 3: {
                REP(4, phase_scan(p, l, lds, tx));
                int k256 = 256; asm volatile("" : "+s"(k256));
                { FRESH_TX(txa); EpiQKV E{(bf16_t*)(ws + WS_R3), (bf16_t*)(ws + WS_KVRAW)}; pg8::Gemm g{(const bf16_t*)(ws + WS_R4), (const bf16_t*)(wt + WS_WT_QUP), T + TKV, INWP, k256};
                  QKVOrder S{p.gx, p.gx - 1 - p.bx}; pg8::gemm_phase<EpiQKV, QKVOrder, false>(lds, g, S, E, nullptr, txa); }
            } break;
            case 4: REP(5, phase_qk_finalize(p, l, lds, tx)); break;
            case 5: REP(6, phase_attn(p, l, lds, tx)); break;
            case 6: if ((RMASK >> 14) & 1) { phase_mix_finalize(p, l, tx, 0, T / 2); xcd_barrier(bar); phase_mix_finalize(p, l, tx, T / 2, T); } else { REP(7, phase_mix_finalize(p, l, tx)); } break;
            case 7: { if ((RMASK >> 16) & 1) { FRESH_TX(txn); EpiNull EN{(float*)(ws + WS_BAR + 8192)}; run_gemm(p, lds, (const bf16_t*)(ws + WS_R2), (const bf16_t*)(wt + WS_WT_OUT), T, 1024, 1024, EN, txn); }
                      EpiResGateN E{xa, xb, p.out, modl + 2048, (bf16_t*)(ws + WS_R3), wtab + (size_t)((l * 2 + 1) * 5) * 1024, rsb + (size_t)(2 * l + 1) * T};
                      run_gemm(p, lds, (const bf16_t*)(ws + WS_R2), (const bf16_t*)(wt + WS_WT_OUT), T, 1024, 1024, E, tx);
                      if (l == 0) { const bool big = p.gx > 224; if (!big || p.bx >= 192) { FRESH_TX(txm); phase_mod(p, lds, txm, 1, big ? p.bx - 192 : p.bx, big ? p.gx - 192 : p.gx); } } } break;
            case 9: { EpiSwiGLU2 E{(bf16_t*)(ws + WS_R1), rsb + (size_t)(2 * l + 1) * T, (const float*)(ws + WS_BGU) + (size_t)l * 5 * 2 * FF};
                      REP(11, run_gemm(p, lds, (const bf16_t*)(ws + WS_R3), (const bf16_t*)(wt + WS_WT_GU), T, 2 * FF, 1024, E, tx));
                      { const bool big = p.gx > 64;
                        if (l == 0 && (!big || p.bx >= 32)) { unsigned z2 = 0u; asm volatile("" : "+v"(z2)); const int tx2 = wv64 + (int)__builtin_amdgcn_mbcnt_hi(~0u, __builtin_amdgcn_mbcnt_lo(~0u, z2)); phase_convert(p, 1, lds, tx2, big ? p.bx - 32 : p.bx, big ? p.gx - 32 : p.gx); }
                        if (l == 0) { FRESH_TX(txt); phase_tables(p, txt, 1); } } } break;
            case 10:
                if ((RMASK >> 15) & 1) { FRESH_TX(txn); EpiNull EN{(float*)(ws + WS_BAR + 8192)}; run_gemm(p, lds, (const bf16_t*)(ws + WS_R1), (const bf16_t*)(wt + WS_WT_DN), T, 1024, FF, EN, txn); }
                if (l == 0) { EpiResGateN E{p.out, p.out + (size_t)TC * D, p.out, modl + 5120, (bf16_t*)(ws + WS_R2), wtab + (size_t)((1 * 2 + 0) * 5) * 1024, rsb + (size_t)2 * T};
                      run_gemm(p, lds, (const bf16_t*)(ws + WS_R1), (const bf16_t*)(wt + WS_WT_DN), T, 1024, FF, E, tx);
                      { const bool big = p.gx > 224; if (!big || p.bx >= 192) { unsigned z2 = 0u; asm volatile("" : "+v"(z2)); const int tx2 = wv64 + (int)__builtin_amdgcn_mbcnt_hi(~0u, __builtin_amdgcn_mbcnt_lo(~0u, z2)); phase_bias(p, 1, big ? p.bx - 192 : p.bx, big ? p.gx - 192 : p.gx, tx2); } } }
                else { EpiResGate E{p.out, p.out + (size_t)TC * D, p.out, modl + 5120}; run_gemm(p, lds, (const bf16_t*)(ws + WS_R1), (const bf16_t*)(wt + WS_WT_DN), T, 1024, FF, E, tx); }
                break;
            }
        }
        if (ph + 1 < pk.ph_hi || pass == 0) { xcd_barrier(bar); if ((RMASK >> 12) & 1) xcd_barrier(bar); }
    }
    }
}

extern "C" void kernel_launch(void* const* d_in, const int* in_sizes, int n_in, void* d_out, int out_size, void* d_ws, size_t ws_size, hipStream_t stream) {
    static int grid_blocks = 0;
    if (!grid_blocks) {
        int dev = 0, cus = 0, per_cu = 0;
        hipGetDevice(&dev);
        hipDeviceGetAttribute(&cus, hipDeviceAttributeMultiprocessorCount, dev);
        hipFuncSetAttribute((const void*)fwd_megakernel, hipFuncAttributeMaxDynamicSharedMemorySize, LDS_BYTES);
        hipOccupancyMaxActiveBlocksPerMultiprocessor(&per_cu, (const void*)fwd_megakernel, NT, LDS_BYTES);
        if (per_cu < 1) per_cu = 1;
        if (per_cu > 1) per_cu = 1;
        grid_blocks = cus * per_cu;
        if (ws_size < WS_TOTAL) fprintf(stderr, "kernel_launch: workspace too small: %zu < %zu\n", ws_size, (size_t)WS_END);
    }
    if (hipMemsetAsync((unsigned char*)d_ws + WS_BAR, 0, 16384, stream) != hipSuccess) fprintf(stderr, "memset failed\n");
    KParams p{};
    for (int i = 0; i < 34; ++i) p.in[i] = (const float*)d_in[i];
    p.out = (float*)d_out; p.ws = (unsigned char*)d_ws; p.ph_lo = 0; p.ph_hi = 20;
    void* args[] = {&p};
    hipError_t e = hipLaunchCooperativeKernel((const void*)fwd_megakernel, dim3(grid_blocks), dim3(NT), args, LDS_BYTES, stream);
    if (e != hipSuccess) fprintf(stderr, "cooperative launch failed: %s (grid %d)\n", hipGetErrorString(e), grid_blocks);
}
```

```cpp
#include <hip/hip_runtime.h>
#include <hip/hip_cooperative_groups.h>
#include <cstdio>
namespace cg = cooperative_groups;

namespace pg8 {
#define PG8_LAS __attribute__((address_space(3)))
typedef unsigned short bf16_t;
typedef short bf16x8 __attribute__((ext_vector_type(8)));
typedef float f32x4 __attribute__((ext_vector_type(4)));
typedef unsigned u32x4 __attribute__((ext_vector_type(4)));
constexpr int BM = 256, BK = 64, HALF = 128, HTB = HALF * BK * 2  , STAGE_BYTES = 8 * HTB, NXCD = 8, WGM = 8;

__host__ __device__ __forceinline__ int lds_byte(int r, int c) { const int st = (r >> 4) * 2 + (c >> 5), rr = r & 15, cc = c & 31, ob = rr * 64 + cc * 2; return st * 1024 + (ob ^ (((ob >> 9) & 1) << 5)); }
__host__ __device__ __forceinline__ void stage_rc(int b, int& R, int& C) { const int st = b / 1024, sb = b % 1024, swz = sb ^ (((sb >> 9) & 1) << 5); R = (st >> 1) * 16 + swz / 64; C = (st & 1) * 32 + (swz % 64) / 2; }
__host__ __device__ __forceinline__ int perm32(int rho) { const int n = rho >> 4, i = rho & 15; return 8 * (i >> 2) + 4 * n + (i & 3); }

struct Unit { int pm, pn; };
struct Gemm { const bf16_t* A; const bf16_t* Bt; int M, N, K; };

struct StaticOrder {
    int nM, nN, nwg, G, c;
    __host__ __device__ void init(int M, int N, int G_, int c_) { nM = M / BM; nN = N / BM; nwg = nM * nN; G = G_; c = c_; }
    __host__ __device__ bool next(int i, Unit& u) const {
        const long L = (long)i * G + c; if (L >= nwg) return false;
        int wgid = (int)L; { const int q = nwg / NXCD, r = nwg % NXCD, xcd = wgid % NXCD, off = wgid / NXCD; wgid = (xcd < r ? xcd * (q + 1) : r * (q + 1) + (xcd - r) * q) + off; }
        const int nig = WGM * nN, gid = wgid / nig, fm = gid * WGM, gsz = (nM - fm) < WGM ? (nM - fm) : WGM;
        u.pm = fm + ((wgid % nig) % gsz); u.pn = (wgid % nig) / gsz; return true;
    }
    __device__ __forceinline__ void a_ready(const Unit&) const {}
    __device__ __forceinline__ void done(const Unit&) const {}
};
__device__ __forceinline__ unsigned cvt_pk_bf16(float lo, float hi) { unsigned r; asm volatile("v_cvt_pk_bf16_f32 %0, %1, %2" : "=v"(r) : "v"(lo), "v"(hi)); return r; }
typedef float f32x2 __attribute__((ext_vector_type(2)));
__device__ __forceinline__ f32x2 gelu_pk(f32x2 v) {
    const f32x2 av = __builtin_elementwise_abs(v), d = av * 0.2316418882f + 1.0f;
    f32x2 t; t.x = __builtin_amdgcn_rcpf(d.x); t.y = __builtin_amdgcn_rcpf(d.y);
    f32x2 q = t * 0.5307027145f + (-0.7265760135f); q = q * t + 0.7107068705f; q = q * t + (-0.142248368f); q = q * t + 0.127414796f; q = q * t;
    const f32x2 s = (v * v) * (-0.72134752044f);
    f32x2 e; e.x = __builtin_amdgcn_exp2f(s.x); e.y = __builtin_amdgcn_exp2f(s.y);
    const f32x2 m = v * (q * e), r = v - m;
    f32x2 o; o.x = v.x < 0.f ? m.x : r.x; o.y = v.y < 0.f ? m.y : r.y; return o;
}
template <int ACT  > struct EpiBf16 {
    static constexpr bool PERM = true, AFTER_DRAIN = false;
    bf16_t* O; int ldc; const float* bias; int split_cols; size_t split_stride;
    __device__ __forceinline__ void operator()(const f32x4 (&acc)[2][2][4][2], const Unit& u, int wr, int wc, int fr, int fq) const {
        const int row0 = u.pm * BM + wr * 64 + fr; int colt = u.pn * BM; bf16_t* base = O;
        if (split_cols) { const int t = colt / split_cols; base += (size_t)t * split_stride; colt -= t * split_cols; }
        const int col0 = colt + wc * 32 + 8 * fq, bcol0 = u.pn * BM + wc * 32 + 8 * fq;
        f32x4 bv[2][2];
#pragma unroll
        for (int bj = 0; bj < 2; ++bj)
#pragma unroll
            for (int n = 0; n < 2; ++n) bv[bj][n] = bias ? *(const f32x4*)(bias + bcol0 + bj * HALF + 4 * n) : (f32x4){0.f, 0.f, 0.f, 0.f};
#pragma unroll
        for (int ai = 0; ai < 2; ++ai)
#pragma unroll
            for (int m = 0; m < 4; ++m) { bf16_t* rowp = base + (size_t)(row0 + ai * HALF + m * 16) * ldc + col0;
#pragma unroll
                for (int bj = 0; bj < 2; ++bj) { f32x4 v0 = acc[ai][bj][m][0] + bv[bj][0], v1 = acc[ai][bj][m][1] + bv[bj][1];
                    if (ACT == 1) { f32x2 a = gelu_pk((f32x2){v0[0], v0[1]}), b = gelu_pk((f32x2){v0[2], v0[3]}), c = gelu_pk((f32x2){v1[0], v1[1]}), d = gelu_pk((f32x2){v1[2], v1[3]});
                        v0 = (f32x4){a.x, a.y, b.x, b.y}; v1 = (f32x4){c.x, c.y, d.x, d.y}; }
                    if (ACT == 2) {
#pragma unroll
                        for (int j = 0; j < 4; ++j) { v0[j] = 0.5f * v0[j] * (1.0f + erff(v0[j] * 0.70710678f)); v1[j] = 0.5f * v1[j] * (1.0f + erff(v1[j] * 0.70710678f)); } }
                    u32x4 w; w.x = cvt_pk_bf16(v0[0], v0[1]); w.y = cvt_pk_bf16(v0[2], v0[3]); w.z = cvt_pk_bf16(v1[0], v1[1]); w.w = cvt_pk_bf16(v1[2], v1[3]);
                    *(u32x4*)(rowp + bj * HALF) = w; } }
    }
};
template <class Epi, class Sched, bool STAMP = false>
__device__ __forceinline__ void gemm_phase(PG8_LAS unsigned char* lds, const Gemm g, const Sched& S, const Epi& E, unsigned long long* stamps, int tid_in) {
    const int tid = tid_in, wid = __builtin_amdgcn_readfirstlane(tid >> 6), lane = tid & 63, wr = wid >> 2, wc = wid & 3, fr = lane & 15, fq = lane >> 4;
    const int K = g.K, nt = K / BK;
    int ts_lo = 0, ts_hi = 0, nts = 0; const unsigned long long rt_entry = STAMP ? (unsigned long long)wall_clock64() : 0ull;
#define PG8_STAMP() do { if (STAMP && wid == 0 && nts < 64) { const unsigned long long _c = (unsigned long long)clock64(); \
        ts_lo = (lane == nts) ? (int)(unsigned)_c : ts_lo; ts_hi = (lane == nts) ? (int)(unsigned)(_c >> 32) : ts_hi; ++nts; } } while (0)
    PG8_STAMP();
    unsigned voffA[2], voffB[2];
#pragma unroll
    for (int i = 0; i < 2; ++i) { int R, C; stage_rc(tid * 16 + i * 8192, R, C); const int Rb = Epi::PERM ? ((R & ~31) + perm32(R & 31)) : R;
        voffA[i] = (unsigned)(R * K + C) * 2u; voffB[i] = (unsigned)(Rb * K + C) * 2u; }
    const size_t kstep = (size_t)(BK * 2);
    const size_t hstep = (size_t)HALF * K * 2;
    const size_t tstep = 2 * hstep;
    const unsigned ldsw = (unsigned)wid * 1024u;
    const int aoff = lds_byte(wr * 64 + fr, fq * 8), boff = lds_byte(wc * 32 + fr, fq * 8);
#define PG8_SA(b, h) (((b) * 2 + (h)) * HTB)
#define PG8_SB(b, h) ((4 + (b) * 2 + (h)) * HTB)
#define PG8_STAGE(bufoff, gbase, voff) do { _Pragma("unroll") for (int _i = 0; _i < 2; ++_i) \
        __builtin_amdgcn_global_load_lds((const unsigned*)((const char*)(gbase) + (voff)[_i]), (PG8_LAS unsigned*)(lds + (bufoff) + ldsw + _i * 8192), 16, 0, 0); } while (0)
#define PG8_LDA(dst, b, h) do { _Pragma("unroll") for (int m = 0; m < 4; ++m) _Pragma("unroll") for (int k = 0; k < 2; ++k) dst[m][k] = *(const PG8_LAS bf16x8*)(lds + PG8_SA(b, h) + aoff + m * 2048 + k * 1024); } while (0)
#define PG8_LDB(dst, b, h) do { _Pragma("unroll") for (int n = 0; n < 2; ++n) _Pragma("unroll") for (int k = 0; k < 2; ++k) dst[n][k] = *(const PG8_LAS bf16x8*)(lds + PG8_SB(b, h) + boff + n * 2048 + k * 1024); } while (0)
#define PG8_MMA(ai, bj, At, Bt) do { __builtin_amdgcn_s_setprio(1); _Pragma("unroll") for (int m = 0; m < 4; ++m) _Pragma("unroll") for (int n = 0; n < 2; ++n) _Pragma("unroll") for (int k = 0; k < 2; ++k) \
        acc[ai][bj][m][n] = __builtin_amdgcn_mfma_f32_16x16x32_bf16(Bt[n][k], At[m][k], acc[ai][bj][m][n], 0, 0, 0); __builtin_amdgcn_s_setprio(0); } while (0)
#define PG8_WAIT_V(n) asm volatile("s_waitcnt vmcnt(" #n ")" ::: "memory")
#define PG8_WAIT_L(n) asm volatile("s_waitcnt lgkmcnt(" #n ")" ::: "memory")
#define PG8_BAR __builtin_amdgcn_s_barrier()
#define PG8_SCHED __builtin_amdgcn_sched_barrier(0)
    Unit cur, nxt; int ui = 0;
    if (!S.next(0, cur)) return;
    f32x4 acc[2][2][4][2];
#pragma unroll
    for (int a = 0; a < 2; ++a)
#pragma unroll
        for (int b = 0; b < 2; ++b)
#pragma unroll
            for (int m = 0; m < 4; ++m)
#pragma unroll
                for (int n = 0; n < 2; ++n) acc[a][b][m][n] = (f32x4){0.f, 0.f, 0.f, 0.f};
    bf16x8 At[4][2], B0[2][2], B1[2][2];
    const char* cA = (const char*)g.A + (size_t)cur.pm * tstep; const char* cB = (const char*)g.Bt + (size_t)cur.pn * tstep;
    S.a_ready(cur);
    PG8_STAGE(PG8_SB(0, 0), cB, voffB); PG8_STAGE(PG8_SA(0, 0), cA, voffA); PG8_STAGE(PG8_SB(0, 1), cB + hstep, voffB); PG8_STAGE(PG8_SA(0, 1), cA + hstep, voffA);
    if (wr == 1) PG8_BAR;
    PG8_WAIT_V(4); PG8_BAR;
    PG8_STAGE(PG8_SB(1, 0), cB + kstep, voffB); PG8_STAGE(PG8_SA(1, 0), cA + kstep, voffA); PG8_STAGE(PG8_SB(1, 1), cB + hstep + kstep, voffB);
    PG8_WAIT_V(6); PG8_BAR;
    PG8_STAMP();
    for (;;) {
        const bool has_next = S.next(ui + 1, nxt);
        const char* nA = has_next ? (const char*)g.A + (size_t)nxt.pm * tstep : cA; const char* nB = has_next ? (const char*)g.Bt + (size_t)nxt.pn * tstep : cB;
        for (int t = 0; t < nt; t += 2) {
            const bool last = (t == nt - 2);
            const char* a1 = cA + (size_t)(t + 1) * kstep;
            const char* a2 = last ? nA : cA + (size_t)(t + 2) * kstep; const char* b2 = last ? nB : cB + (size_t)(t + 2) * kstep;
            const char* a3 = a2 + kstep; const char* b3 = b2 + kstep;
            if (last && has_next) S.a_ready(nxt);
            PG8_LDB(B0, 0, 0); PG8_SCHED; PG8_LDA(At, 0, 0); PG8_STAGE(PG8_SA(1, 1), a1 + hstep, voffA);
            PG8_WAIT_L(8); PG8_BAR; PG8_WAIT_L(0); PG8_MMA(0, 0, At, B0); PG8_BAR; PG8_SCHED;
            PG8_LDB(B1, 0, 1); PG8_STAGE(PG8_SB(0, 0), b2, voffB);
            PG8_BAR; PG8_WAIT_L(0); PG8_MMA(0, 1, At, B1); PG8_BAR;
            PG8_LDA(At, 0, 1); PG8_STAGE(PG8_SA(0, 0), a2, voffA);
            PG8_BAR; PG8_WAIT_L(0); PG8_MMA(1, 0, At, B0); PG8_BAR; PG8_SCHED;
            PG8_STAGE(PG8_SB(0, 1), b2 + hstep, voffB);
            PG8_WAIT_V(6); PG8_BAR; PG8_MMA(1, 1, At, B1); PG8_BAR;
            PG8_LDB(B0, 1, 0); PG8_SCHED; PG8_LDA(At, 1, 0); PG8_STAGE(PG8_SA(0, 1), a2 + hstep, voffA);
            PG8_WAIT_L(8); PG8_BAR; PG8_WAIT_L(0); PG8_MMA(0, 0, At, B0); PG8_BAR; PG8_SCHED;
            PG8_LDB(B1, 1, 1); PG8_STAGE(PG8_SB(1, 0), b3, voffB);
            PG8_BAR; PG8_WAIT_L(0); PG8_MMA(0, 1, At, B1); PG8_BAR;
            PG8_LDA(At, 1, 1); PG8_STAGE(PG8_SA(1, 0), a3, voffA);
            PG8_BAR; PG8_WAIT_L(0); PG8_MMA(1, 0, At, B0); PG8_BAR; PG8_SCHED;
            PG8_STAGE(PG8_SB(1, 1), b3 + hstep, voffB);
            PG8_WAIT_V(6); PG8_BAR; PG8_MMA(1, 1, At, B1); PG8_BAR;
        }
        PG8_STAMP();
        if constexpr (!Epi::AFTER_DRAIN) { unsigned zl_ = 0u; asm volatile("" : "+v"(zl_)); const int l2_ = (int)__builtin_amdgcn_mbcnt_hi(~0u, __builtin_amdgcn_mbcnt_lo(~0u, zl_));
            E(acc, cur, wr, wc, l2_ & 15, l2_ >> 4); S.done(cur); }
        PG8_STAMP();
        if (!has_next) break;
#pragma unroll
        for (int a = 0; a < 2; ++a)
#pragma unroll
            for (int b = 0; b < 2; ++b)
#pragma unroll
                for (int m = 0; m < 4; ++m)
#pragma unroll
                    for (int n = 0; n < 2; ++n) acc[a][b][m][n] = (f32x4){0.f, 0.f, 0.f, 0.f};
        cur = nxt; cA = nA; cB = nB; ++ui;
    }
    PG8_WAIT_V(0);
    if (wr == 0) PG8_BAR;
    PG8_BAR;
    if constexpr (Epi::AFTER_DRAIN) { E.fused(acc, cur, wr, wc, fr, fq, lds, wid, lane); S.done(cur); }
    PG8_STAMP();
    if (STAMP && wid == 0) { stamps[lane] = lane < nts ? (((unsigned long long)(unsigned)ts_hi << 32) | (unsigned)ts_lo) : 0ull;
        if (lane == 62) stamps[62] = rt_entry; if (lane == 63) stamps[63] = (unsigned long long)wall_clock64(); }
#undef PG8_STAMP
#undef PG8_SA
#undef PG8_SB
#undef PG8_STAGE
#undef PG8_LDA
#undef PG8_LDB
#undef PG8_MMA
#undef PG8_WAIT_V
#undef PG8_WAIT_L
#undef PG8_BAR
#undef PG8_SCHED
}
}

#define DI __device__ __forceinline__
#define LAS __attribute__((address_space(3)))
typedef unsigned short bf16_t;
typedef short bf16x8 __attribute__((ext_vector_type(8)));
typedef short s16x4 __attribute__((ext_vector_type(4)));
typedef float f32x4 __attribute__((ext_vector_type(4)));
typedef float f32x16 __attribute__((ext_vector_type(16)));
typedef unsigned u32x4 __attribute__((ext_vector_type(4)));
typedef unsigned u32x2 __attribute__((ext_vector_type(2)));

#ifndef PREFIX
#define PREFIX 0
#endif
#ifndef PFLAG
#define PFLAG 0
#endif
#ifndef RMASK
#define RMASK 0
#endif
#define FRESH_TX(name) unsigned name##_z = 0u; asm volatile("" : "+v"(name##_z)); const int name = wv64 + (int)__builtin_amdgcn_mbcnt_hi(~0u, __builtin_amdgcn_mbcnt_lo(~0u, name##_z))
#define REP(bit, ...) do { __VA_ARGS__; if ((RMASK >> (bit)) & 1) { __syncthreads(); __VA_ARGS__; } } while (0)
constexpr int NT = 512;
constexpr int D = 1024, TC = 8192, TLAT = 4096, T = TC + TLAT, TKV = T + 1024;
constexpr int INW = 1696, INWP = 1792, FF = 2816;
constexpr int LDS_STAGE = 131072, LDS_BYTES = LDS_STAGE + 16;
constexpr float EPS = 1e-6f;
constexpr float QSCALE = 0.10206207261596577f * 1.4426950408889634f;

constexpr size_t WS_WT_IN = 0;
constexpr size_t WS_WT_QUP = WS_WT_IN + (size_t)INWP * 1024 * 2;
constexpr size_t WS_WT_KVUP = WS_WT_QUP + (size_t)768 * 256 * 2;
constexpr size_t WS_WT_OUT = WS_WT_KVUP + (size_t)1024 * 256 * 2;
constexpr size_t WS_WT_GU = WS_WT_OUT + (size_t)1024 * 1024 * 2;
constexpr size_t WS_WT_DN = WS_WT_GU + (size_t)2 * FF * 1024 * 2;
constexpr size_t WS_MOD = WS_WT_DN + (size_t)1024 * FF * 2;
constexpr size_t WS_R1 = WS_MOD + (size_t)2 * 5 * 6144 * 4;
constexpr size_t WS_XC = WS_R1 + (size_t)T * INWP * 2;
constexpr size_t WS_R2 = WS_R1 + (size_t)T * FF * 2;
constexpr size_t WS_R3 = WS_R2 + (size_t)T * 1024 * 2;
constexpr size_t WS_KVRAW = WS_R3 + (size_t)T * 768 * 2;
constexpr size_t WS_R4 = WS_KVRAW + (size_t)TKV * 1024 * 2;
constexpr size_t WS_CKV = WS_R4 + (size_t)T * 256 * 2;
constexpr size_t WS_K = WS_R4 + (size_t)T * 768 * 2;
constexpr size_t WS_VT = WS_K + (size_t)TKV * 768 * 2;
constexpr size_t WS_HF = WS_VT + (size_t)TKV * 512 * 2;
constexpr size_t WS_END = WS_HF + (size_t)2 * T * 256 * 4;
constexpr size_t WS_BAR = WS_END;
constexpr size_t WS_WT2 = WS_BAR + 16384;
constexpr size_t WS_RS = WS_WT2 + WS_MOD;
constexpr size_t WS_BIN = WS_RS + (size_t)4 * T * 4;
constexpr size_t WS_BGU = WS_BIN + (size_t)2 * 5 * INWP * 4;
constexpr size_t WS_WTAB = WS_BGU + (size_t)2 * 5 * 2 * FF * 4;
constexpr size_t WS_TOTAL = WS_WTAB + (size_t)2 * 2 * 5 * 1024 * 4;
static_assert(WS_TOTAL <= (size_t)256 * 1024 * 1024, "workspace too large");
static_assert((size_t)T * 256 * 2 + (size_t)TKV * 256 * 2 <= (size_t)T * 768 * 2, "QLAT+CKV must fit in Q region");

constexpr size_t OUT_CKV = (size_t)T * 1024, OUT_KR = OUT_CKV + (size_t)32 * 2 * 256 * 128, OUT_ST = OUT_KR + (size_t)32 * 2 * 256 * 32;

struct KParams { const float* in[34]; float* out; unsigned char* ws; int ph_lo, ph_hi; };
struct Params { const float* in[34]; float* out; unsigned char* ws; int bx, gx; };
enum { I_XP = 0, I_XS, I_CCKV, I_CKR, I_STATE, I_C, I_CCTX, I_N1G, I_ADAW, I_ADAB, I_WIN, I_CONVW, I_CONVB, I_LCW, I_LCB, I_LWA, I_LBA, I_LWI, I_LBI, I_LAM,
       I_QNG, I_WQUP, I_KVNG, I_WKVUP, I_QHG, I_KHG, I_GNC, I_GNL, I_GNM, I_WOUT, I_N2G, I_WG, I_WU, I_WD };

DI unsigned pack2(float lo, float hi) {
    typedef __bf16 bf2 __attribute__((ext_vector_type(2))); typedef float f2 __attribute__((ext_vector_type(2)));
    f2 v = {lo, hi}; bf2 b = __builtin_convertvector(v, bf2); return __builtin_bit_cast(unsigned, b);
}
DI float bf2f(unsigned short b) { return __uint_as_float(((unsigned)b) << 16); }
DI float bflo(unsigned w) { return __uint_as_float(w << 16); }
DI float bfhi(unsigned w) { return __uint_as_float(w & 0xffff0000u); }
DI float wave_sum(float v) {
#pragma unroll
    for (int o = 32; o >= 1; o >>= 1) v += __shfl_xor(v, o);
    return v;
}
#define MFMA32(a, b, c) __builtin_amdgcn_mfma_f32_32x32x16_bf16((a), (b), (c), 0, 0, 0)
DI float sigmoidf_(float x) { return 1.0f / (1.0f + __expf(-x)); }

DI void phase_mod(const Params& p, LAS unsigned char* lds, int tx, int lsel, int first, int nblk) {
    const int tid = tx;
    LAS float* sc = (LAS float*)lds;
    LAS float* red = (LAS float*)(lds + 20480);
    for (int i = tid; i < 5 * 1024; i += NT) { const int ci = i >> 10, k = i & 1023; const float v = (ci == 0) ? p.in[I_CCTX][k] : p.in[I_C][(ci - 1) * 1024 + k]; sc[i] = v / (1.0f + __expf(-v)); }
    __syncthreads();
    float* mod = (float*)(p.ws + WS_MOD);
    const int cg = tid & 15, kg = tid >> 4;
    for (int unit = first; unit < 96; unit += nblk) {
        const int l = lsel, n0 = unit * 64;
        const float* w = p.in[I_ADAW] + (size_t)l * 1024 * 6144 + n0 + 4 * cg;
        f32x4 a0 = {0.f, 0.f, 0.f, 0.f}, a1 = a0, a2 = a0, a3 = a0, a4 = a0;
#pragma unroll 8
        for (int k = kg * 32; k < kg * 32 + 32; ++k) { const f32x4 wv = *(const f32x4*)(w + (size_t)k * 6144); a0 += sc[k] * wv; a1 += sc[1024 + k] * wv; a2 += sc[2048 + k] * wv; a3 += sc[3072 + k] * wv; a4 += sc[4096 + k] * wv; }
#pragma unroll
        for (int q = 0; q < 4; ++q) { LAS float* r = red + (kg * 64 + 4 * cg + q) * 5; r[0] = a0[q]; r[1] = a1[q]; r[2] = a2[q]; r[3] = a3[q]; r[4] = a4[q]; }
        __syncthreads();
        if (tid < 320) { const int c = tid >> 6, c2 = tid & 63; float sum = 0.f;
#pragma unroll
            for (int g = 0; g < 32; ++g) sum += red[(g * 64 + c2) * 5 + c];
            mod[(size_t)(l * 5 + c) * 6144 + n0 + c2] = sum + p.in[I_ADAB][l * 6144 + n0 + c2]; }
        __syncthreads();
    }
}

DI void cvt_tile(const float* __restrict__ src, bf16_t* __restrict__ dst, int K, int N, int Kpad, int kt, int nt, int mode, LAS unsigned char* lds, int tx) {
    LAS float* tile = (LAS float*)lds;
    const int tid = tx, cx = tid & 63, ty = tid >> 6;
    float v[16];
#pragma unroll
    for (int i = 0; i < 16; ++i) { const int k = kt * 128 + ty + 8 * i, n = nt * 64 + cx; v[i] = (k < K && n < N) ? src[(size_t)k * N + n] : 0.f; }
#pragma unroll
    for (int i = 0; i < 16; ++i) tile[(ty + 8 * i) * 65 + cx] = v[i];
    __syncthreads();
#pragma unroll
    for (int it = 0; it < 2; ++it) {
        const int item = tid + 512 * it, nl = item >> 4, kc = (item & 15) * 8, n = nt * 64 + nl;
        u32x4 w;
        w.x = pack2(tile[(kc + 0) * 65 + nl], tile[(kc + 1) * 65 + nl]); w.y = pack2(tile[(kc + 2) * 65 + nl], tile[(kc + 3) * 65 + nl]);
        w.z = pack2(tile[(kc + 4) * 65 + nl], tile[(kc + 5) * 65 + nl]); w.w = pack2(tile[(kc + 6) * 65 + nl], tile[(kc + 7) * 65 + nl]);
        const int R = (mode == 0) ? n : (256 * (n >> 7) + 128 * (mode - 1) + (n & 127));
        *(u32x4*)(dst + (size_t)R * Kpad + kt * 128 + kc) = w;
    }
    __syncthreads();
}
DI void phase_convert(const Params& p, int l, LAS unsigned char* lds, int tx, int first, int nblk, int ulo = 0, int uhi = 1 << 30) {
    unsigned char* wsl = p.ws + (l ? WS_WT2 : 0);
    const int c0 = 8 * 28, c1 = c0 + 2 * 12, c2 = c1 + 2 * 16, c3 = c2 + 8 * 16, c4 = c3 + 8 * 44, c5 = c4 + 8 * 44, c6 = c5 + 22 * 16;
    for (int u = ulo + first; u < c6 && u < uhi; u += nblk) {
        if (u < c0)      { const int v = u;      cvt_tile(p.in[I_WIN] + (size_t)l * 1024 * INW, (bf16_t*)(wsl + WS_WT_IN), 1024, INW, 1024, v % 8, v / 8, 0, lds, tx); }
        else if (u < c1) { const int v = u - c0; cvt_tile(p.in[I_WQUP] + (size_t)l * 256 * 768, (bf16_t*)(wsl + WS_WT_QUP), 256, 768, 256, v % 2, v / 2, 0, lds, tx); }
        else if (u < c2) { const int v = u - c1; cvt_tile(p.in[I_WKVUP] + (size_t)l * 128 * 1024, (bf16_t*)(wsl + WS_WT_KVUP), 128, 1024, 256, v % 2, v / 2, 0, lds, tx); }
        else if (u < c3) { const int v = u - c2; cvt_tile(p.in[I_WOUT] + (size_t)l * 1024 * 1024, (bf16_t*)(wsl + WS_WT_OUT), 1024, 1024, 1024, v % 8, v / 8, 0, lds, tx); }
        else if (u < c4) { const int v = u - c3; cvt_tile(p.in[I_WG] + (size_t)l * 1024 * FF, (bf16_t*)(wsl + WS_WT_GU), 1024, FF, 1024, v % 8, v / 8, 1, lds, tx); }
        else if (u < c5) { const int v = u - c4; cvt_tile(p.in[I_WU] + (size_t)l * 1024 * FF, (bf16_t*)(wsl + WS_WT_GU), 1024, FF, 1024, v % 8, v / 8, 2, lds, tx); }
        else             { const int v = u - c5; cvt_tile(p.in[I_WD] + (size_t)l * FF * 1024, (bf16_t*)(wsl + WS_WT_DN), FF, 1024, FF, v % 22, v / 22, 0, lds, tx); }
    }
}

DI void phase_prep0(const Params& p, const float* __restrict__ xa, const float* __restrict__ xb, const float* __restrict__ g, const float* __restrict__ modl, int scoff, int tx) {
    const int lane = tx & 63, wave = tx >> 6;
    bf16_t* __restrict__ HN = (bf16_t*)(p.ws + WS_R2);
    float* __restrict__ rs = (float*)(p.ws + WS_RS);
    for (int rb = (p.bx * 8 + wave) * 3; rb < T; rb += p.gx * 8 * 3) {
        f32x4 v[3][4];
#pragma unroll
        for (int q = 0; q < 3; ++q) { const int r = rb + q; const float* x = (r < TC) ? xa + (size_t)r * D : xb + (size_t)(r - TC) * D;
#pragma unroll
            for (int i = 0; i < 4; ++i) v[q][i] = *(const f32x4*)(x + 4 * (lane + 64 * i)); }
#pragma unroll
        for (int q = 0; q < 3; ++q) { const int r = rb + q; const int ci = (r < TC) ? 0 : 1 + ((r - TC) >> 10);
            float ss = 0.f;
#pragma unroll
            for (int i = 0; i < 4; ++i) ss += v[q][i][0] * v[q][i][0] + v[q][i][1] * v[q][i][1] + v[q][i][2] * v[q][i][2] + v[q][i][3] * v[q][i][3];
            ss = wave_sum(ss);
            if (lane == 0) rs[r] = ss;
#pragma unroll
            for (int i = 0; i < 4; ++i) { const int col = 4 * (lane + 64 * i);
                const f32x4 gv = *(const f32x4*)(g + col), sc = *(const f32x4*)(modl + ci * 6144 + scoff + col);
                const f32x4 y = v[q][i] * (gv * (sc + 1.0f));
                u32x2 w; w.x = pack2(y[0], y[1]); w.y = pack2(y[2], y[3]);
                *(u32x2*)(HN + (size_t)r * D + col) = w; } }
    }
}
DI void phase_tables(const Params& p, int tx, int lsel) {
    float* wtab = (float*)(p.ws + WS_WTAB); const float* mod = (const float*)(p.ws + WS_MOD);
#pragma unroll
    for (int kq = 0; kq < 4; ++kq) { const int i = (kq * p.gx + p.bx) * NT + tx; if (i >= 2 * 2 * 5 * 1024) continue;
        const int col = i & 1023, ci = (i >> 10) % 5, which = ((i >> 10) / 5) & 1, l = (i >> 10) / 10; if (l != lsel) continue;
        const float g = (which ? p.in[I_N2G] : p.in[I_N1G])[l * 1024 + col];
        wtab[i] = g * (1.0f + mod[(size_t)(l * 5 + ci) * 6144 + (which ? 4096 : 1024) + col]);
    }
}
DI void phase_zero_rs(const Params& p, int tx) {
    float* rs = (float*)(p.ws + WS_RS) + T;
#pragma unroll
    for (int k = 0; k < 4; ++k) { const int i = (k * p.gx + p.bx) * NT + tx; if (i < 3 * T) rs[i] = 0.f; }
}
DI void bias_rows(const bf16_t* __restrict__ WT, const float* __restrict__ sh  , float* __restrict__ out, int N, int gw, int nw, int lane) {
    float sv[5][16];
#pragma unroll
    for (int ci = 0; ci < 5; ++ci)
#pragma unroll
        for (int i = 0; i < 4; ++i) { const f32x4 t = *(const f32x4*)(sh + ci * 6144 + lane * 16 + 4 * i); sv[ci][4 * i] = t[0]; sv[ci][4 * i + 1] = t[1]; sv[ci][4 * i + 2] = t[2]; sv[ci][4 * i + 3] = t[3]; }
    for (int n0 = gw * 4; n0 < N; n0 += nw * 4) {
        u32x4 w0[4], w1[4];
#pragma unroll
        for (int q = 0; q < 4; ++q) { w0[q] = *(const u32x4*)(WT + (size_t)(n0 + q) * 1024 + lane * 16); w1[q] = *(const u32x4*)(WT + (size_t)(n0 + q) * 1024 + lane * 16 + 8); }
#pragma unroll
        for (int q = 0; q < 4; ++q) {
            const float wf[16] = {bflo(w0[q].x), bfhi(w0[q].x), bflo(w0[q].y), bfhi(w0[q].y), bflo(w0[q].z), bfhi(w0[q].z), bflo(w0[q].w), bfhi(w0[q].w), bflo(w1[q].x), bfhi(w1[q].x), bflo(w1[q].y), bfhi(w1[q].y), bflo(w1[q].z), bfhi(w1[q].z), bflo(w1[q].w), bfhi(w1[q].w)};
            float d[5];
#pragma unroll
            for (int ci = 0; ci < 5; ++ci) { float a = 0.f;
#pragma unroll
                for (int i = 0; i < 16; ++i) a += sv[ci][i] * wf[i];
                d[ci] = a; }
#pragma unroll
            for (int o = 32; o >= 1; o >>= 1) { d[0] += __shfl_xor(d[0], o); d[1] += __shfl_xor(d[1], o); d[2] += __shfl_xor(d[2], o); d[3] += __shfl_xor(d[3], o); d[4] += __shfl_xor(d[4], o); }
            const float val = lane == 0 ? d[0] : lane == 1 ? d[1] : lane == 2 ? d[2] : lane == 3 ? d[3] : d[4];
            if (lane < 5) out[(size_t)lane * N + n0 + q] = val;
        }
    }
}
DI void phase_bias(const Params& p, int l, int first, int nblk, int tx, int parts = 3) {
    const int lane = tx & 63, wave = tx >> 6;
    const unsigned char* wt = p.ws + (l ? WS_WT2 : 0);
    const float* modl = (const float*)(p.ws + WS_MOD) + (size_t)l * 5 * 6144;
    if (parts & 1) bias_rows((const bf16_t*)(wt + WS_WT_IN), modl + 0, (float*)(p.ws + WS_BIN) + (size_t)l * 5 * INWP, INWP, first * 8 + wave, nblk * 8, lane);
    if (parts & 2) bias_rows((const bf16_t*)(wt + WS_WT_GU), modl + 3072, (float*)(p.ws + WS_BGU) + (size_t)l * 5 * 2 * FF, 2 * FF, first * 8 + wave, nblk * 8, lane);
}

DI void phase_post_in(const Params& p, int l, int tx) {
    const int lane = tx & 63, wave = tx >> 6;
    const bf16_t* __restrict__ U = (const bf16_t*)(p.ws + WS_R1);
    bf16_t* __restrict__ QLAT = (bf16_t*)(p.ws + WS_R4);
    bf16_t* __restrict__ CKV = (bf16_t*)(p.ws + WS_CKV);
    float* __restrict__ out = p.out;
    const f32x4 qgv = *(const f32x4*)(p.in[I_QNG] + l * 256 + 4 * lane);
    const float kg0 = p.in[I_KVNG][l * 128 + 2 * lane], kg1 = p.in[I_KVNG][l * 128 + 2 * lane + 1];
    for (int rb = (p.bx * 8 + wave) * 4; rb < T + 1024; rb += p.gx * 8 * 4) {
        if (rb < T) {
            u32x2 qw[4]; unsigned cw[4]; unsigned short kr[4];
#pragma unroll
            for (int q = 0; q < 4; ++q) { const bf16_t* u = U + (size_t)(rb + q) * INWP; qw[q] = *(const u32x2*)(u + 1280 + 4 * lane); cw[q] = *(const unsigned*)(u + 1536 + 2 * lane); kr[q] = u[1664 + (lane & 31)]; }
#pragma unroll
            for (int q = 0; q < 4; ++q) { const int r = rb + q;
                const float a = bflo(qw[q].x), b = bfhi(qw[q].x), c = bflo(qw[q].y), d = bfhi(qw[q].y), e = bflo(cw[q]), f = bfhi(cw[q]);
                float s1 = a * a + b * b + c * c + d * d, s2 = e * e + f * f;
#pragma unroll
                for (int o = 32; o >= 1; o >>= 1) { s1 += __shfl_xor(s1, o); s2 += __shfl_xor(s2, o); }
                const float i1 = rsqrtf(s1 * (1.0f / 256.0f) + EPS), i2 = rsqrtf(s2 * (1.0f / 128.0f) + EPS);
                u32x2 o; o.x = pack2(a * i1 * qgv[0], b * i1 * qgv[1]); o.y = pack2(c * i1 * qgv[2], d * i1 * qgv[3]);
                *(u32x2*)(QLAT + (size_t)r * 256 + 4 * lane) = o;
                const float y0 = e * i2 * kg0, y1 = f * i2 * kg1;
                *(unsigned*)(CKV + (size_t)r * 256 + 2 * lane) = pack2(y0, y1);
                *(unsigned*)(CKV + (size_t)r * 256 + 128 + 2 * lane) = 0u;
                if (r < TC) { const int b_ = r >> 8, sq = r & 255; typedef float f32x2_ __attribute__((ext_vector_type(2))); *(f32x2_*)(out + OUT_CKV + ((size_t)(b_ * 2 + l) * 256 + sq) * 128 + 2 * lane) = (f32x2_){y0, y1};
                    if (lane < 32) out[OUT_KR + ((size_t)(b_ * 2 + l) * 256 + sq) * 32 + lane] = bf2f(kr[q]); }
            }
        } else {
#pragma unroll
            for (int q = 0; q < 4; ++q) { const int r = rb + q, rc = r - T, b_ = rc >> 8, sq = rc & 255;
                const float* src = p.in[I_CCKV] + ((size_t)(b_ * 2 + l) * 256 + sq) * 128 + 2 * lane;
                *(unsigned*)(CKV + (size_t)r * 256 + 2 * lane) = pack2(src[0], src[1]);
                *(unsigned*)(CKV + (size_t)r * 256 + 128 + 2 * lane) = 0u; }
        }
    }
}

DI void gates_unit(const Params& p, int l, int tt128, int n, int dir, LAS unsigned char* lds, int tx, const bf16x8 (&wfa)[4], const bf16x8 (&wfi)[4], float ba, float bi, float sp) {
    const int tid = tx, lane = tid & 63, wave = tid >> 6, r32 = lane & 31, half = lane >> 5, tt = wave >> 1, jt = wave & 1;
    const bf16_t* __restrict__ U = (const bf16_t*)(p.ws + WS_R1);
    float* __restrict__ Ab = (float*)(p.ws + WS_R2) + (size_t)dir * T * 256;
    float* __restrict__ Bb = (float*)(p.ws + WS_XC) + (size_t)dir * T * 256;
    LAS float* xs = (LAS float*)lds;
    LAS unsigned char* xb = lds + 32768;
    const float* cw = p.in[I_LCW] + l * 4 * 256 + n * 64; const float* cb = p.in[I_LCB] + l * 256 + n * 64;
    const int r0 = tt128 * 128;
#pragma unroll
    for (int it = 0; it < 2; ++it) {
        const int item = tid + 512 * it, tl = item >> 3, cg = (item & 7) * 8, r = r0 + tl;
        const int s = (r < TC) ? (r & 255) : ((r - TC) & 1023), S = (r < TC) ? 256 : 1024;
        f32x4 a0 = *(const f32x4*)(cb + cg), a1 = *(const f32x4*)(cb + cg + 4);
#pragma unroll
        for (int k = 0; k < 4; ++k) { const int sk = s + k - 2;
            if (sk >= 0 && sk < S) { const u32x4 w = *(const u32x4*)(U + (size_t)(r + k - 2) * INWP + 768 + n * 64 + cg);
                const f32x4 w0 = *(const f32x4*)(cw + k * 256 + cg), w1 = *(const f32x4*)(cw + k * 256 + cg + 4);
                a0[0] += w0[0] * bflo(w.x); a0[1] += w0[1] * bfhi(w.x); a0[2] += w0[2] * bflo(w.y); a0[3] += w0[3] * bfhi(w.y);
                a1[0] += w1[0] * bflo(w.z); a1[1] += w1[1] * bfhi(w.z); a1[2] += w1[2] * bflo(w.w); a1[3] += w1[3] * bfhi(w.w); } }
        *(LAS f32x4*)(xs + tl * 64 + cg) = a0; *(LAS f32x4*)(xs + tl * 64 + cg + 4) = a1;
        u32x4 pw; pw.x = pack2(a0[0], a0[1]); pw.y = pack2(a0[2], a0[3]); pw.z = pack2(a1[0], a1[1]); pw.w = pack2(a1[2], a1[3]);
        *(LAS u32x4*)(xb + tl * 144 + cg * 2) = pw;
    }
    __syncthreads();
    f32x16 za, zi;
#pragma unroll
    for (int i = 0; i < 16; ++i) { za[i] = ba; zi[i] = bi; }
#pragma unroll
    for (int kk = 0; kk < 4; ++kk) {
        const bf16x8 af = *(const LAS bf16x8*)(xb + (tt * 32 + r32) * 144 + (kk * 16 + 8 * half) * 2);
        za = MFMA32(af, wfa[kk], za); zi = MFMA32(af, wfi[kk], zi);
    }
    const int c = n * 64 + jt * 32 + r32;
#pragma unroll
    for (int i = 0; i < 16; ++i) {
        const int tl = tt * 32 + (i & 3) + 8 * (i >> 2) + 4 * half, r = r0 + tl;
        const float xj = xs[tl * 64 + jt * 32 + r32];
        const float rr = __builtin_amdgcn_rcpf(1.0f + __builtin_amdgcn_exp2f(-1.4426950408889634f * za[i]));
        const float ii = __builtin_amdgcn_rcpf(1.0f + __builtin_amdgcn_exp2f(-1.4426950408889634f * zi[i]));
        const float la = -8.0f * rr * sp;
        const float a = __builtin_amdgcn_exp2f(1.4426950408889634f * la);
        const float bt = __builtin_amdgcn_sqrtf(-expm1f(2.0f * la)) * (ii * xj);
        Ab[(size_t)r * 256 + c] = a; Bb[(size_t)r * 256 + c] = bt;
    }
    __syncthreads();
}
DI void gates_load_w(const Params& p, int l, int n, int dir, int tx, bf16x8 (&wfa)[4], bf16x8 (&wfi)[4], float& ba, float& bi, float& sp) {
    const int lane = tx & 63, wave = tx >> 6, r32 = lane & 31, half = lane >> 5, jt = wave & 1, j = jt * 32 + r32;
    const float* wap = p.in[I_LWA] + ((size_t)((l * 2 + dir) * 4 + n) * 64) * 64 + j;
    const float* wip = p.in[I_LWI] + ((size_t)((l * 2 + dir) * 4 + n) * 64) * 64 + j;
#pragma unroll
    for (int kk = 0; kk < 4; ++kk) { u32x4 wa_, wi_; const int k0 = kk * 16 + 8 * half;
        wa_.x = pack2(wap[(k0 + 0) * 64], wap[(k0 + 1) * 64]); wa_.y = pack2(wap[(k0 + 2) * 64], wap[(k0 + 3) * 64]); wa_.z = pack2(wap[(k0 + 4) * 64], wap[(k0 + 5) * 64]); wa_.w = pack2(wap[(k0 + 6) * 64], wap[(k0 + 7) * 64]);
        wi_.x = pack2(wip[(k0 + 0) * 64], wip[(k0 + 1) * 64]); wi_.y = pack2(wip[(k0 + 2) * 64], wip[(k0 + 3) * 64]); wi_.z = pack2(wip[(k0 + 4) * 64], wip[(k0 + 5) * 64]); wi_.w = pack2(wip[(k0 + 6) * 64], wip[(k0 + 7) * 64]);
        wfa[kk] = __builtin_bit_cast(bf16x8, wa_); wfi[kk] = __builtin_bit_cast(bf16x8, wi_); }
    const int c = n * 64 + j;
    ba = p.in[I_LBA][(l * 2 + dir) * 256 + c]; bi = p.in[I_LBI][(l * 2 + dir) * 256 + c];
    sp = log1pf(__expf(-p.in[I_LAM][(l * 2 + dir) * 256 + c]));
}
DI void phase_gates(const Params& p, int l, LAS unsigned char* lds, int tx) {
    bf16x8 wfa[4], wfi[4]; float ba, bi, sp;
    if ((p.gx & 7) == 0) {
        const int n = (p.bx >> 1) & 3, dir = p.bx & 1;
        gates_load_w(p, l, n, dir, tx, wfa, wfi, ba, bi, sp);
        for (int u = p.bx; u < 96 * 8; u += p.gx) gates_unit(p, l, u >> 3, n, dir, lds, tx, wfa, wfi, ba, bi, sp);
    } else {
        for (int u = p.bx; u < 96 * 8; u += p.gx) { const int n = (u >> 1) & 3, dir = u & 1;
            gates_load_w(p, l, n, dir, tx, wfa, wfi, ba, bi, sp);
            gates_unit(p, l, u >> 3, n, dir, lds, tx, wfa, wfi, ba, bi, sp); }
    }
}
template <int CH, int LC> DI void scan_unit(const Params& p, int l, int sigma, int dir, int cbase, LAS unsigned char* lds, int tx) {
    constexpr int NCH = 512 / CH;
    const int tid = tx, j = tid % CH, chunk = tid / CH;
    const int S = LC * NCH, row0 = (sigma < 32) ? sigma * 256 : TC + (sigma - 32) * 1024;
    const int c = cbase + j;
    const float* __restrict__ Ab = (const float*)(p.ws + WS_R2) + (size_t)dir * T * 256 + c;
    const float* __restrict__ Bb = (const float*)(p.ws + WS_XC) + (size_t)dir * T * 256 + c;
    float* __restrict__ Hb = (float*)(p.ws + WS_HF) + (size_t)dir * T * 256 + c;
    const float h0 = (sigma < 32) ? 0.f : p.in[I_STATE][((size_t)((sigma - 32) * 2 + l) * 2 + dir) * 256 + c];
    const int tau0 = chunk * LC;
    const long step = dir ? -256 : 256;
    const long off0 = (long)(row0 + (dir ? (S - 1 - tau0) : tau0)) * 256;
    float av[LC], bv[LC];
#pragma unroll
    for (int q = 0; q < LC; ++q) { av[q] = Ab[off0 + (long)q * step]; bv[q] = Bb[off0 + (long)q * step]; }
    float H = 0.f, P = 1.f;
#pragma unroll
    for (int q = 0; q < LC; ++q) { H = av[q] * H + bv[q]; P *= av[q]; }
    LAS float* sP = (LAS float*)lds; LAS float* sH = sP + 512;
    sP[chunk * CH + j] = P; sH[chunk * CH + j] = H;
    __syncthreads();
    float h = h0;
    for (int cc = 0; cc < chunk; ++cc) h = sP[cc * CH + j] * h + sH[cc * CH + j];
#pragma unroll
    for (int q = 0; q < LC; ++q) { h = av[q] * h + bv[q]; Hb[off0 + (long)q * step] = h; }
    if (chunk == NCH - 1 && sigma < 32) p.out[OUT_ST + ((size_t)(sigma * 2 + l) * 2 + dir) * 256 + c] = h;
    __syncthreads();
}
DI void phase_scan(const Params& p, int l, LAS unsigned char* lds, int tx) {
    for (int u = p.bx; u < 320; u += p.gx) {
        if (u < 64) scan_unit<32, 64>(p, l, 32 + (u >> 4), (u >> 3) & 1, (u & 7) * 32, lds, tx);
        else { const int v = u - 64; scan_unit<64, 32>(p, l, v >> 3, (v >> 2) & 1, (v & 3) * 64, lds, tx); }
    }
}

DI void seq_of_row(int r, int& base, int& key, int& Sk) {
    if (r < TC) { base = (r >> 8) * 256; key = r & 255; Sk = 256; }
    else if (r < T) { const int b = (r - TC) >> 10; base = TC + b * 1280; key = (r - TC) & 1023; Sk = 1280; }
    else { const int b = (r - T) >> 8; base = TC + b * 1280; key = 1024 + ((r - T) & 255); Sk = 1280; }
}
DI void phase_qk_finalize(const Params& p, int l, LAS unsigned char* lds, int tx) {
    const int tid = tx, lane = tid & 63, wave = tid >> 6, h = lane >> 3, j = lane & 7;
    const bf16_t* __restrict__ U = (const bf16_t*)(p.ws + WS_R1);
    const bf16_t* __restrict__ QRAW = (const bf16_t*)(p.ws + WS_R3);
    const bf16_t* __restrict__ KVRAW = (const bf16_t*)(p.ws + WS_KVRAW);
    bf16_t* __restrict__ Q = (bf16_t*)(p.ws + WS_R4);
    bf16_t* __restrict__ K = (bf16_t*)(p.ws + WS_K);
    bf16_t* __restrict__ VT = (bf16_t*)(p.ws + WS_VT);
    const float* qhg = p.in[I_QHG] + l * 96; const float* khg = p.in[I_KHG] + l * 96;
    LAS bf16_t* Vs = (LAS bf16_t*)lds;
    float qg[12], kg[12];
#pragma unroll
    for (int i = 0; i < 12; ++i) { qg[i] = qhg[j + 8 * i]; kg[i] = khg[j + 8 * i]; }
    const float invf = __builtin_amdgcn_exp2f(-1.6609640474436813f * (float)j);
    for (int unit = p.bx; unit < TKV / 64; unit += p.gx) {
        const bool mainrow = (unit * 64 < T);
        for (int hb = 0; hb < 2; ++hb) {
            const int rbase = unit * 64 + wave * 8 + hb * 4;
            float qv[4][12], kv[4][12]; u32x4 vw[4];
#pragma unroll
            for (int q = 0; q < 4; ++q) { const int r = rbase + q;
                if (mainrow) {
#pragma unroll
                    for (int i = 0; i < 12; ++i) qv[q][i] = bf2f(QRAW[(size_t)r * 768 + h * 96 + j + 8 * i]);
#pragma unroll
                    for (int i = 0; i < 4; ++i) kv[q][8 + i] = bf2f(U[(size_t)r * INWP + 1664 + j + 8 * i]);
                } else { const int rc = r - T, b_ = rc >> 8, s = rc & 255;
#pragma unroll
                    for (int i = 0; i < 12; ++i) qv[q][i] = 0.f;
#pragma unroll
                    for (int i = 0; i < 4; ++i) kv[q][8 + i] = p.in[I_CKR][((size_t)(b_ * 2 + l) * 256 + s) * 32 + j + 8 * i]; }
#pragma unroll
                for (int i = 0; i < 8; ++i) kv[q][i] = bf2f(KVRAW[(size_t)r * 1024 + h * 128 + j + 8 * i]);
                vw[q] = *(const u32x4*)(KVRAW + (size_t)r * 1024 + h * 128 + 64 + j * 8);
            }
#pragma unroll
            for (int q = 0; q < 4; ++q) { const int r = rbase + q;
                int base, key, Sk; seq_of_row(r, base, key, Sk);
                const bool rope = (r >= TC && r < T);
                float c0 = 1.f, s0 = 0.f, c1 = 1.f, s1 = 0.f;
                if (rope) { const int s = (r - TC) & 1023; const float a0 = (float)(s >> 6) * invf, a1 = (float)(s & 63) * invf; c0 = __cosf(a0); s0 = __sinf(a0); c1 = __cosf(a1); s1 = __sinf(a1); }
                float sq = 0.f, sk = 0.f;
#pragma unroll
                for (int i = 0; i < 12; ++i) { sq += qv[q][i] * qv[q][i]; sk += kv[q][i] * kv[q][i]; }
                sq += __shfl_xor(sq, 1); sk += __shfl_xor(sk, 1); sq += __shfl_xor(sq, 2); sk += __shfl_xor(sk, 2); sq += __shfl_xor(sq, 4); sk += __shfl_xor(sk, 4);
                const float iq = rsqrtf(sq * (1.0f / 96.0f) + EPS) * QSCALE, ik = rsqrtf(sk * (1.0f / 96.0f) + EPS);
#pragma unroll
                for (int i = 0; i < 12; ++i) { qv[q][i] = qv[q][i] * iq * qg[i]; kv[q][i] = kv[q][i] * ik * kg[i]; }
                if (rope) {
                    { const float x1 = qv[q][8], x2 = qv[q][9], x3 = qv[q][10], x4 = qv[q][11];
                      qv[q][8] = x1 * c0 - x2 * s0; qv[q][9] = x2 * c0 + x1 * s0; qv[q][10] = x3 * c1 - x4 * s1; qv[q][11] = x4 * c1 + x3 * s1; }
                    { const float x1 = kv[q][8], x2 = kv[q][9], x3 = kv[q][10], x4 = kv[q][11];
                      kv[q][8] = x1 * c0 - x2 * s0; kv[q][9] = x2 * c0 + x1 * s0; kv[q][10] = x3 * c1 - x4 * s1; kv[q][11] = x4 * c1 + x3 * s1; }
                }
                if (mainrow) {
#pragma unroll
                    for (int i = 0; i < 12; ++i) Q[((size_t)r * 8 + h) * 96 + j + 8 * i] = (bf16_t)(pack2(qv[q][i], 0.f) & 0xffffu);
                }
                bf16_t* kd = K + ((size_t)base * 8 + (size_t)h * Sk + key) * 96;
#pragma unroll
                for (int i = 0; i < 12; ++i) kd[j + 8 * i] = (bf16_t)(pack2(kv[q][i], 0.f) & 0xffffu);
                *(LAS u32x4*)(Vs + (wave * 8 + hb * 4 + q) * 520 + lane * 8) = vw[q];
            }
        }
        __syncthreads();
        {
            int base, key, Sk; seq_of_row(unit * 64, base, key, Sk);
            const int hh = tid >> 6, d = tid & 63;
            bf16_t* vd = VT + ((size_t)base * 8 + (size_t)hh * Sk) * 64 + (size_t)d * Sk + key;
#pragma unroll
            for (int q = 0; q < 8; ++q) { u32x4 w;
                w.x = (unsigned)Vs[(q * 8 + 0) * 520 + tid] | ((unsigned)Vs[(q * 8 + 1) * 520 + tid] << 16);
                w.y = (unsigned)Vs[(q * 8 + 2) * 520 + tid] | ((unsigned)Vs[(q * 8 + 3) * 520 + tid] << 16);
                w.z = (unsigned)Vs[(q * 8 + 4) * 520 + tid] | ((unsigned)Vs[(q * 8 + 5) * 520 + tid] << 16);
                w.w = (unsigned)Vs[(q * 8 + 6) * 520 + tid] | ((unsigned)Vs[(q * 8 + 7) * 520 + tid] << 16);
                *(u32x4*)(vd + q * 8) = w; }
        }
        __syncthreads();
    }
}

DI void attn_unit(const Params& p, int base, int Sk, int h, int qrow0, LAS unsigned char* lds, int tx, float negmB) {
    const int tid = tx, lane = tid & 63, wave = tid >> 6, grp = wave >> 2, wq = wave & 3, r32 = lane & 31, half = lane >> 5, gt = tid & 255;
    const bf16_t* __restrict__ Q = (const bf16_t*)(p.ws + WS_R4);
    const bf16_t* __restrict__ Kg = (const bf16_t*)(p.ws + WS_K) + ((size_t)base * 8 + (size_t)h * Sk) * 96;
    const bf16_t* __restrict__ Vg = (const bf16_t*)(p.ws + WS_VT) + ((size_t)base * 8 + (size_t)h * Sk) * 64;
    bf16_t* __restrict__ O = (bf16_t*)(p.ws + WS_R3);
    LAS unsigned char* Ks = lds + grp * 22528;
    LAS unsigned char* Vs = Ks + 13312;
    const int qrow = qrow0 + wq * 32 + r32;
    bf16x8 Qf[6];
#pragma unroll
    for (int kk = 0; kk < 6; ++kk) Qf[kk] = *(const bf16x8*)(Q + ((size_t)qrow * 8 + h) * 96 + 16 * kk + 8 * half);
    int kr[3], kcc[3], vd[2], vcc[2];
#pragma unroll
    for (int i = 0; i < 3; ++i) { const int c = gt + 256 * i; kr[i] = c / 12; kcc[i] = c % 12; }
#pragma unroll
    for (int i = 0; i < 2; ++i) { const int c = gt + 256 * i; vd[i] = c >> 3; vcc[i] = c & 7; }
    f32x16 o0, o1;
#pragma unroll
    for (int i = 0; i < 16; ++i) { o0[i] = 0.f; o1[i] = 0.f; }
    float lsum = 0.f;
    const int nit = Sk >> 7;
    u32x4 kreg[3], vreg[2];
    {   const bf16_t* kn = Kg + (size_t)grp * 64 * 96;
#pragma unroll
        for (int i = 0; i < 3; ++i) kreg[i] = *(const u32x4*)(kn + (size_t)kr[i] * 96 + kcc[i] * 8);
#pragma unroll
        for (int i = 0; i < 2; ++i) vreg[i] = *(const u32x4*)(Vg + (size_t)vd[i] * Sk + grp * 64 + vcc[i] * 8); }
    for (int it = 0; it < nit; ++it) {
        __syncthreads();
#pragma unroll
        for (int i = 0; i < 3; ++i) *(LAS u32x4*)(Ks + kr[i] * 208 + kcc[i] * 16) = kreg[i];
#pragma unroll
        for (int i = 0; i < 2; ++i) *(LAS u32x4*)(Vs + vd[i] * 144 + vcc[i] * 16) = vreg[i];
        __syncthreads();
        if (it + 1 < nit) {
            const int kt = 2 * (it + 1) + grp;
            const bf16_t* kn = Kg + (size_t)kt * 64 * 96;
#pragma unroll
            for (int i = 0; i < 3; ++i) kreg[i] = *(const u32x4*)(kn + (size_t)kr[i] * 96 + kcc[i] * 8);
#pragma unroll
            for (int i = 0; i < 2; ++i) vreg[i] = *(const u32x4*)(Vg + (size_t)vd[i] * Sk + kt * 64 + vcc[i] * 8);
        }
        f32x16 s0, s1;
#pragma unroll
        for (int i = 0; i < 16; ++i) { s0[i] = negmB; s1[i] = negmB; }
#pragma unroll
        for (int kk = 0; kk < 6; ++kk) {
            const bf16x8 a0 = *(const LAS bf16x8*)(Ks + r32 * 208 + (16 * kk + 8 * half) * 2);
            const bf16x8 a1 = *(const LAS bf16x8*)(Ks + (32 + r32) * 208 + (16 * kk + 8 * half) * 2);
            s0 = MFMA32(a0, Qf[kk], s0); s1 = MFMA32(a1, Qf[kk], s1);
        }
        float ps = 0.f;
#pragma unroll
        for (int i = 0; i < 16; ++i) { s0[i] = __builtin_amdgcn_exp2f(s0[i]); s1[i] = __builtin_amdgcn_exp2f(s1[i]); ps += s0[i] + s1[i]; }
        lsum += ps;
#pragma unroll
        for (int kt2 = 0; kt2 < 2; ++kt2) {
#pragma unroll
            for (int s = 0; s < 2; ++s) {
                u32x4 pw;
                if (kt2 == 0) { pw.x = pack2(s0[8 * s], s0[8 * s + 1]); pw.y = pack2(s0[8 * s + 2], s0[8 * s + 3]); pw.z = pack2(s0[8 * s + 4], s0[8 * s + 5]); pw.w = pack2(s0[8 * s + 6], s0[8 * s + 7]); }
                else          { pw.x = pack2(s1[8 * s], s1[8 * s + 1]); pw.y = pack2(s1[8 * s + 2], s1[8 * s + 3]); pw.z = pack2(s1[8 * s + 4], s1[8 * s + 5]); pw.w = pack2(s1[8 * s + 6], s1[8 * s + 7]); }
                const bf16x8 pb = __builtin_bit_cast(bf16x8, pw);
                const int koff = (32 * kt2 + 16 * s + 4 * half) * 2;
                const s16x4 v0lo = *(const LAS s16x4*)(Vs + r32 * 144 + koff), v0hi = *(const LAS s16x4*)(Vs + r32 * 144 + koff + 16);
                const s16x4 v1lo = *(const LAS s16x4*)(Vs + (32 + r32) * 144 + koff), v1hi = *(const LAS s16x4*)(Vs + (32 + r32) * 144 + koff + 16);
                const bf16x8 va0 = __builtin_shufflevector(v0lo, v0hi, 0, 1, 2, 3, 4, 5, 6, 7), va1 = __builtin_shufflevector(v1lo, v1hi, 0, 1, 2, 3, 4, 5, 6, 7);
                o0 = MFMA32(va0, pb, o0); o1 = MFMA32(va1, pb, o1);
            }
        }
    }
    lsum += __shfl_xor(lsum, 32);
    LAS float* cb = (LAS float*)lds + (size_t)(wq * 34) * 64 + lane;
    __syncthreads();
    if (grp == 1) {
#pragma unroll
        for (int i = 0; i < 16; ++i) { cb[i * 64] = o0[i]; cb[(16 + i) * 64] = o1[i]; }
        cb[33 * 64] = lsum;
    }
    __syncthreads();
    if (grp == 0) {
        const float inv = 1.0f / (lsum + cb[33 * 64]);
        const float w0 = inv, w1 = inv;
        bf16_t* orow = O + (size_t)qrow * 512 + h * 64 + 4 * half;
#pragma unroll
        for (int g = 0; g < 4; ++g) {
            f32x4 a = {o0[4 * g] * w0 + cb[(4 * g) * 64] * w1, o0[4 * g + 1] * w0 + cb[(4 * g + 1) * 64] * w1, o0[4 * g + 2] * w0 + cb[(4 * g + 2) * 64] * w1, o0[4 * g + 3] * w0 + cb[(4 * g + 3) * 64] * w1};
            f32x4 b = {o1[4 * g] * w0 + cb[(16 + 4 * g) * 64] * w1, o1[4 * g + 1] * w0 + cb[(16 + 4 * g + 1) * 64] * w1, o1[4 * g + 2] * w0 + cb[(16 + 4 * g + 2) * 64] * w1, o1[4 * g + 3] * w0 + cb[(16 + 4 * g + 3) * 64] * w1};
            u32x2 wa_, wb_; wa_.x = pack2(a[0], a[1]); wa_.y = pack2(a[2], a[3]); wb_.x = pack2(b[0], b[1]); wb_.y = pack2(b[2], b[3]);
            *(u32x2*)(orow + 8 * g) = wa_; *(u32x2*)(orow + 32 + 8 * g) = wb_;
        }
    }
}
DI void attn_dispatch(const Params& p, int u, LAS unsigned char* lds, int tx, float negmB) {
    if (u < 256) { const int b = u >> 6, h = (u >> 3) & 7, qb = u & 7; attn_unit(p, TC + b * 1280, 1280, h, TC + b * 1024 + qb * 128, lds, tx, negmB); }
    else { const int v = u - 256, sg = v >> 4, h = (v >> 1) & 7, hf = v & 1; attn_unit(p, sg * 256, 256, h, sg * 256 + hf * 128, lds, tx, negmB); }
}
DI void phase_attn(const Params& p, int l, LAS unsigned char* lds, int tx) {
    const int G = p.gx, b = p.bx;
    float gq = 0.f, gk = 0.f;
    for (int i = 0; i < 96; ++i) { gq = fmaxf(gq, fabsf(p.in[I_QHG][l * 96 + i])); gk = fmaxf(gk, fabsf(p.in[I_KHG][l * 96 + i])); }
    const float negmB = -fminf((96.0f * QSCALE) * gq * gk * 1.01f, 64.0f);
    if (G == 256) {
        const int x = b & 7, j = b >> 3, pair = x * 4 + (j >> 3), ul = (pair >> 3) * 64 + (pair & 7) * 8 + (j & 7);
        attn_dispatch(p, ul, lds, tx, negmB); attn_dispatch(p, 256 + 2 * b, lds, tx, negmB); attn_dispatch(p, 256 + 2 * b + 1, lds, tx, negmB); }
    else { for (int u = b; u < 768; u += G) attn_dispatch(p, u, lds, tx, negmB); }
}

DI float gelu_tanh(float x) { const float u = 0.7978845608028654f * (x + 0.044715f * x * x * x); const float e = __expf(2.0f * u); const float t = 1.0f - 2.0f / (e + 1.0f); return 0.5f * x * (1.0f + t); }
struct MixRow { u32x2 cg[3], hh[3], bg, yb, p0, p1; f32x4 hf, hb; };
DI MixRow mix_load(const bf16_t* __restrict__ U, const float* __restrict__ HF, const float* __restrict__ HB, const bf16_t* __restrict__ O, int r, int c) {
    MixRow m;
    const int s = (r < TC) ? (r & 255) : ((r - TC) & 1023), S = (r < TC) ? 256 : 1024;
#pragma unroll
    for (int k = 0; k < 3; ++k) { const int sk = s + k - 1; const bool ok = (sk >= 0 && sk < S); const bf16_t* u = U + (size_t)(r + (ok ? k - 1 : 0)) * INWP;
        const u32x2 z = {0u, 0u}; const u32x2 a = *(const u32x2*)(u + 256 + c), b = *(const u32x2*)(u + 512 + c); m.cg[k] = ok ? a : z; m.hh[k] = ok ? b : z; }
    m.bg = *(const u32x2*)(U + (size_t)r * INWP + c); m.yb = *(const u32x2*)(U + (size_t)r * INWP + 1024 + c);
    m.hf = *(const f32x4*)(HF + (size_t)r * 256 + c); m.hb = *(const f32x4*)(HB + (size_t)r * 256 + c);
    m.p0 = *(const u32x2*)(O + (size_t)r * 512 + c); m.p1 = *(const u32x2*)(O + (size_t)r * 512 + 256 + c);
    return m;
}
DI void mix_store(const MixRow& m, bf16_t* __restrict__ Y, int r, int c, const f32x4 (&wv)[3], const f32x4& cbv, const f32x4& gcv, const f32x4& glv, const f32x4& gm0, const f32x4& gm1) {
    const f32x4 o0 = {bflo(m.p0.x), bfhi(m.p0.x), bflo(m.p0.y), bfhi(m.p0.y)}, o1 = {bflo(m.p1.x), bfhi(m.p1.x), bflo(m.p1.y), bfhi(m.p1.y)};
    f32x4 acc = cbv;
#pragma unroll
    for (int k = 0; k < 3; ++k) { acc[0] += wv[k][0] * (bflo(m.cg[k].x) * bflo(m.hh[k].x)); acc[1] += wv[k][1] * (bfhi(m.cg[k].x) * bfhi(m.hh[k].x));
        acc[2] += wv[k][2] * (bflo(m.cg[k].y) * bflo(m.hh[k].y)); acc[3] += wv[k][3] * (bfhi(m.cg[k].y) * bfhi(m.hh[k].y)); }
    const f32x4 y1 = {bflo(m.bg.x) * acc[0], bfhi(m.bg.x) * acc[1], bflo(m.bg.y) * acc[2], bfhi(m.bg.y) * acc[3]};
    const f32x4 y2 = {(m.hf[0] + m.hb[0]) * gelu_tanh(bflo(m.yb.x)), (m.hf[1] + m.hb[1]) * gelu_tanh(bfhi(m.yb.x)), (m.hf[2] + m.hb[2]) * gelu_tanh(bflo(m.yb.y)), (m.hf[3] + m.hb[3]) * gelu_tanh(bfhi(m.yb.y))};
    float s1 = y1[0] * y1[0] + y1[1] * y1[1] + y1[2] * y1[2] + y1[3] * y1[3];
    float s2 = y2[0] * y2[0] + y2[1] * y2[1] + y2[2] * y2[2] + y2[3] * y2[3];
    float s3 = o0[0] * o0[0] + o0[1] * o0[1] + o0[2] * o0[2] + o0[3] * o0[3] + o1[0] * o1[0] + o1[1] * o1[1] + o1[2] * o1[2] + o1[3] * o1[3];
#pragma unroll
    for (int o = 32; o >= 1; o >>= 1) { s1 += __shfl_xor(s1, o); s2 += __shfl_xor(s2, o); s3 += __shfl_xor(s3, o); }
    const float i1 = rsqrtf(s1 * (1.0f / 256.0f) + EPS), i2 = rsqrtf(s2 * (1.0f / 256.0f) + EPS), i3 = rsqrtf(s3 * (1.0f / 512.0f) + EPS);
    u32x2 o;
    o.x = pack2(y1[0] * i1 * gcv[0], y1[1] * i1 * gcv[1]); o.y = pack2(y1[2] * i1 * gcv[2], y1[3] * i1 * gcv[3]); *(u32x2*)(Y + (size_t)r * D + c) = o;
    o.x = pack2(y2[0] * i2 * glv[0], y2[1] * i2 * glv[1]); o.y = pack2(y2[2] * i2 * glv[2], y2[3] * i2 * glv[3]); *(u32x2*)(Y + (size_t)r * D + 256 + c) = o;
    o.x = pack2(o0[0] * i3 * gm0[0], o0[1] * i3 * gm0[1]); o.y = pack2(o0[2] * i3 * gm0[2], o0[3] * i3 * gm0[3]); *(u32x2*)(Y + (size_t)r * D + 512 + c) = o;
    o.x = pack2(o1[0] * i3 * gm1[0], o1[1] * i3 * gm1[1]); o.y = pack2(o1[2] * i3 * gm1[2], o1[3] * i3 * gm1[3]); *(u32x2*)(Y + (size_t)r * D + 768 + c) = o;
}
DI void phase_mix_finalize(const Params& p, int l, int tx, int rlo = 0, int rhi = T) {
    const int lane = tx & 63, wave = tx >> 6, c = 4 * lane;
    const bf16_t* __restrict__ U = (const bf16_t*)(p.ws + WS_R1);
    const float* __restrict__ HF = (const float*)(p.ws + WS_HF); const float* __restrict__ HB = HF + (size_t)T * 256;
    const bf16_t* __restrict__ O = (const bf16_t*)(p.ws + WS_R3);
    bf16_t* __restrict__ Y = (bf16_t*)(p.ws + WS_R2);
    const float* cw = p.in[I_CONVW] + l * 3 * 256;
    f32x4 wv[3];
#pragma unroll
    for (int k = 0; k < 3; ++k) wv[k] = *(const f32x4*)(cw + k * 256 + c);
    const f32x4 cbv = *(const f32x4*)(p.in[I_CONVB] + l * 256 + c), gcv = *(const f32x4*)(p.in[I_GNC] + l * 256 + c), glv = *(const f32x4*)(p.in[I_GNL] + l * 256 + c);
    const f32x4 gm0 = *(const f32x4*)(p.in[I_GNM] + l * 512 + c), gm1 = *(const f32x4*)(p.in[I_GNM] + l * 512 + 256 + c);
    for (int rb = rlo + (p.bx * 8 + wave) * 2; rb < rhi; rb += p.gx * 8 * 2) {
        const MixRow m0 = mix_load(U, HF, HB, O, rb, c), m1 = mix_load(U, HF, HB, O, rb + 1, c);
        mix_store(m0, Y, rb, c, wv, cbv, gcv, glv, gm0, gm1);
        mix_store(m1, Y, rb + 1, c, wv, cbv, gcv, glv, gm0, gm1);
    }
}

#define XB_TMO      128
#define XB_XCNT(j)  (256  + 64 * (j))
#define XB_XSUB(j)  (1280 + 64 * (j))
#define XB_XGEN(j)  (2304 + 64 * (j))
#define XB_TOP      3328
#define XB_TOPGEN   3392
#define XCD_BAR_WORDS 3456
#define XB_SPIN_CAP (1u << 18)
__device__ __forceinline__ unsigned xb_ld(unsigned* p)              { return __hip_atomic_load(p, __ATOMIC_RELAXED, __HIP_MEMORY_SCOPE_AGENT); }
__device__ __forceinline__ unsigned xb_add(unsigned* p, unsigned v) { return __hip_atomic_fetch_add(p, v, __ATOMIC_RELAXED, __HIP_MEMORY_SCOPE_AGENT); }
__device__ __forceinline__ unsigned xb_xcc_id() { return (unsigned)__builtin_amdgcn_s_getreg((3 << 11) | 20) & 0xFu; }
#define XB_SPIN(cond, bar) do { unsigned _sp = 0; while (cond) { __builtin_amdgcn_s_sleep(1); \
    if ((++_sp & 255u) == 0u) { if (xb_ld(&(bar)[XB_TMO])) break; if (_sp > XB_SPIN_CAP) { atomicAdd(&(bar)[XB_TMO], 1u); break; } } } } while (0)

struct XcdBarrier {
    unsigned* bar; unsigned x;
    volatile LAS unsigned* st;
};

__device__ __forceinline__ XcdBarrier xcd_barrier_post(unsigned* bar, volatile LAS unsigned* st) {
    XcdBarrier b; b.bar = bar; b.x = xb_xcc_id(); b.st = st;
    if (threadIdx.x == 0) (void)xb_add(&bar[XB_XCNT(b.x)], 1u);
    return b;
}
__device__ __forceinline__ void xcd_barrier_complete(unsigned* bar, unsigned x, unsigned& nloc, unsigned& nx) {
    const unsigned G = gridDim.x * gridDim.y * gridDim.z;
    unsigned sum, cnt, mine, sp = 0u;
    for (;;) {
        sum = 0u; cnt = 0u; mine = 0u;
#pragma unroll
        for (unsigned j = 0; j < 16; ++j) { const unsigned c = xb_ld(&bar[XB_XCNT(j)]); sum += c; cnt += (c > 0u) ? 1u : 0u; mine = (j == x) ? c : mine; }
        if (sum == G) break;
        __builtin_amdgcn_s_sleep(1);
        if ((++sp & 255u) == 0u) { if (xb_ld(&bar[XB_TMO])) break; if (sp > XB_SPIN_CAP) { atomicAdd(&bar[XB_TMO], 1u); break; } }
    }
    nloc = mine > 0u ? mine : 1u; nx = cnt > 0u ? cnt : 1u;
}

__device__ __forceinline__ void xcd_barrier(const XcdBarrier& b) {
    asm volatile("s_waitcnt vmcnt(0)" ::: "memory");
    __syncthreads();
    if (threadIdx.x == 0) {
        unsigned* bar = b.bar;
        __builtin_amdgcn_s_waitcnt(0);
        unsigned nloc = b.st[0], nx = b.st[1];
        if (nloc == 0u) { xcd_barrier_complete(bar, b.x, nloc, nx); b.st[0] = nloc; b.st[1] = nx; }
        const unsigned old = xb_add(&bar[XB_XSUB(b.x)], 1u);
        const unsigned gen = old / nloc;
        if (old + 1u == (gen + 1u) * nloc) {
            __builtin_amdgcn_fence(__ATOMIC_RELEASE, "agent");
            asm volatile("s_waitcnt vmcnt(0)" ::: "memory");
            const unsigned og = xb_add(&bar[XB_TOP], 1u);
            const unsigned tg = og / nx;
            if (og + 1u == (tg + 1u) * nx) xb_add(&bar[XB_TOPGEN], 1u);
            else XB_SPIN(xb_ld(&bar[XB_TOPGEN]) == tg, bar);
            __builtin_amdgcn_fence(__ATOMIC_ACQUIRE, "agent");
            xb_add(&bar[XB_XGEN(b.x)], 1u);
            asm volatile("s_waitcnt vmcnt(0)" ::: "memory");
        } else {
            XB_SPIN(xb_ld(&bar[XB_XGEN(b.x)]) == gen, bar);
            __builtin_amdgcn_fence(__ATOMIC_ACQUIRE, "agent");
            asm volatile("s_waitcnt vmcnt(0)" ::: "memory");
        }
    }
    __syncthreads();
}

struct EpiResGate {
    static constexpr bool PERM = true, AFTER_DRAIN = false;
    const float* xa; const float* xb; float* out; const float* gate;
    __device__ __forceinline__ void operator()(const pg8::f32x4 (&acc)[2][2][4][2], const pg8::Unit& u, int wr, int wc, int fr, int fq) const {
        const int row0 = u.pm * 256 + wr * 64 + fr, col0 = u.pn * 256 + wc * 32 + 8 * fq;
        const int ci = (u.pm < 32) ? 0 : 1 + ((u.pm - 32) >> 2);
        const float* __restrict__ xin = (u.pm < 32) ? xa : (xb - (size_t)TC * D);
        float* __restrict__ o = out;
        pg8::f32x4 gv[2][2];
#pragma unroll
        for (int bj = 0; bj < 2; ++bj)
#pragma unroll
            for (int n = 0; n < 2; ++n) gv[bj][n] = *(const pg8::f32x4*)(gate + ci * 6144 + col0 + bj * 128 + 4 * n);
#pragma unroll
        for (int ai = 0; ai < 2; ++ai) {
            pg8::f32x4 xv[4][2][2];
#pragma unroll
            for (int m = 0; m < 4; ++m) { const size_t off = (size_t)(row0 + ai * 128 + m * 16) * D + col0;
#pragma unroll
                for (int bj = 0; bj < 2; ++bj)
#pragma unroll
                    for (int n = 0; n < 2; ++n) xv[m][bj][n] = *(const pg8::f32x4*)(xin + off + bj * 128 + 4 * n); }
            asm volatile("" ::: "memory");
#pragma unroll
            for (int m = 0; m < 4; ++m) { const size_t off = (size_t)(row0 + ai * 128 + m * 16) * D + col0;
#pragma unroll
                for (int bj = 0; bj < 2; ++bj)
#pragma unroll
                    for (int n = 0; n < 2; ++n) *(pg8::f32x4*)(o + off + bj * 128 + 4 * n) = xv[m][bj][n] + gv[bj][n] * acc[ai][bj][m][n]; }
            asm volatile("" ::: "memory");
        }
    }
};
struct EpiSwiGLU {
    static constexpr bool PERM = false, AFTER_DRAIN = false;
    bf16_t* G;
    __device__ __forceinline__ void operator()(const pg8::f32x4 (&acc)[2][2][4][2], const pg8::Unit& u, int wr, int wc, int fr, int fq) const {
        const int row0 = u.pm * 256 + wr * 64 + fr, colg0 = u.pn * 128 + wc * 16 + 4 * fq;
#pragma unroll
        for (int ai = 0; ai < 2; ++ai)
#pragma unroll
            for (int m = 0; m < 4; ++m) { bf16_t* rowp = G + (size_t)(row0 + ai * 128 + m * 16) * FF + colg0;
#pragma unroll
                for (int bj = 0; bj < 2; ++bj) { const pg8::f32x4 g = acc[ai][bj][m][0], up = acc[ai][bj][m][1];
                    float y[4];
#pragma unroll
                    for (int i = 0; i < 4; ++i) y[i] = g[i] / (1.0f + __expf(-g[i])) * up[i];
                    u32x2 w; w.x = pack2(y[0], y[1]); w.y = pack2(y[2], y[3]);
                    *(u32x2*)(rowp + bj * 64) = w; } }
    }
};

DI int cond_of_pm(int pm) { return (pm < 32) ? 0 : 1 + ((pm - 32) >> 2); }
struct EpiIn {
    static constexpr bool PERM = true, AFTER_DRAIN = false;
    bf16_t* O; const float* rs; const float* bias;
    __device__ __forceinline__ void operator()(const pg8::f32x4 (&acc)[2][2][4][2], const pg8::Unit& u, int wr, int wc, int fr, int fq) const {
        const int row0 = u.pm * 256 + wr * 64 + fr, col0 = u.pn * 256 + wc * 32 + 8 * fq;
        const float* bp = bias + cond_of_pm(u.pm) * INWP + col0;
        pg8::f32x4 bv[2][2]; float inv[2][4];
#pragma unroll
        for (int bj = 0; bj < 2; ++bj)
#pragma unroll
            for (int n = 0; n < 2; ++n) bv[bj][n] = *(const pg8::f32x4*)(bp + bj * 128 + 4 * n);
#pragma unroll
        for (int ai = 0; ai < 2; ++ai)
#pragma unroll
            for (int m = 0; m < 4; ++m) inv[ai][m] = rs[row0 + ai * 128 + m * 16];
#pragma unroll
        for (int ai = 0; ai < 2; ++ai)
#pragma unroll
            for (int m = 0; m < 4; ++m) { const float iv = rsqrtf(inv[ai][m] * (1.0f / 1024.0f) + EPS); bf16_t* rowp = O + (size_t)(row0 + ai * 128 + m * 16) * INWP + col0;
#pragma unroll
                for (int bj = 0; bj < 2; ++bj) { const pg8::f32x4 v0 = acc[ai][bj][m][0] * iv + bv[bj][0], v1 = acc[ai][bj][m][1] * iv + bv[bj][1];
                    u32x4 w; w.x = pack2(v0[0], v0[1]); w.y = pack2(v0[2], v0[3]); w.z = pack2(v1[0], v1[1]); w.w = pack2(v1[2], v1[3]);
                    *(u32x4*)(rowp + bj * 128) = w; } }
    }
};
struct EpiSwiGLU2 {
    static constexpr bool PERM = true, AFTER_DRAIN = false;
    bf16_t* G; const float* rs; const float* bias;
    __device__ __forceinline__ void operator()(const pg8::f32x4 (&acc)[2][2][4][2], const pg8::Unit& u, int wr, int wc, int fr, int fq) const {
        const int row0 = u.pm * 256 + wr * 64 + fr, colg0 = u.pn * 128 + wc * 32 + 8 * fq;
        const float* bp = bias + cond_of_pm(u.pm) * 2 * FF + u.pn * 256 + wc * 32 + 8 * fq;
        pg8::f32x4 bv[2][2]; float inv[2][4];
#pragma unroll
        for (int bj = 0; bj < 2; ++bj)
#pragma unroll
            for (int n = 0; n < 2; ++n) bv[bj][n] = *(const pg8::f32x4*)(bp + bj * 128 + 4 * n);
#pragma unroll
        for (int ai = 0; ai < 2; ++ai)
#pragma unroll
            for (int m = 0; m < 4; ++m) inv[ai][m] = rs[row0 + ai * 128 + m * 16];
#pragma unroll
        for (int ai = 0; ai < 2; ++ai)
#pragma unroll
            for (int m = 0; m < 4; ++m) { const float iv = rsqrtf(inv[ai][m] * (1.0f / 1024.0f) + EPS);
                float y[8];
#pragma unroll
                for (int n = 0; n < 2; ++n) { const pg8::f32x4 g = acc[ai][0][m][n] * iv + bv[0][n], up = acc[ai][1][m][n] * iv + bv[1][n];
#pragma unroll
                    for (int i = 0; i < 4; ++i) y[4 * n + i] = g[i] * __builtin_amdgcn_rcpf(1.0f + __builtin_amdgcn_exp2f(-1.4426950408889634f * g[i])) * up[i]; }
                u32x4 w; w.x = pack2(y[0], y[1]); w.y = pack2(y[2], y[3]); w.z = pack2(y[4], y[5]); w.w = pack2(y[6], y[7]);
                *(u32x4*)(G + (size_t)(row0 + ai * 128 + m * 16) * FF + colg0) = w; }
    }
};
struct EpiResGateN {
    static constexpr bool PERM = true, AFTER_DRAIN = false;
    const float* xa; const float* xb; float* out; const float* gate; bf16_t* An; const float* wtab; float* rs;
    __device__ __forceinline__ void operator()(const pg8::f32x4 (&acc)[2][2][4][2], const pg8::Unit& u, int wr, int wc, int fr, int fq) const {
        const int row0 = u.pm * 256 + wr * 64 + fr, col0 = u.pn * 256 + wc * 32 + 8 * fq;
        const int ci = cond_of_pm(u.pm);
        const float* __restrict__ xin = (u.pm < 32) ? xa : (xb - (size_t)TC * D);
        float* __restrict__ o = out; bf16_t* __restrict__ an = An;
        pg8::f32x4 gv[2][2], wv[2][2];
#pragma unroll
        for (int bj = 0; bj < 2; ++bj)
#pragma unroll
            for (int n = 0; n < 2; ++n) { gv[bj][n] = *(const pg8::f32x4*)(gate + ci * 6144 + col0 + bj * 128 + 4 * n); wv[bj][n] = *(const pg8::f32x4*)(wtab + ci * 1024 + col0 + bj * 128 + 4 * n); }
#pragma unroll
        for (int ai = 0; ai < 2; ++ai)
#pragma unroll
            for (int mh = 0; mh < 2; ++mh) {
                pg8::f32x4 xv[2][2][2];
#pragma unroll
                for (int mm = 0; mm < 2; ++mm) { const size_t off = (size_t)(row0 + ai * 128 + (2 * mh + mm) * 16) * D + col0;
#pragma unroll
                    for (int bj = 0; bj < 2; ++bj)
#pragma unroll
                        for (int n = 0; n < 2; ++n) xv[mm][bj][n] = *(const pg8::f32x4*)(xin + off + bj * 128 + 4 * n); }
                asm volatile("" ::: "memory");
#pragma unroll
                for (int mm = 0; mm < 2; ++mm) { const int m = 2 * mh + mm; const int row = row0 + ai * 128 + m * 16; const size_t off = (size_t)row * D + col0;
                    float ss = 0.f;
#pragma unroll
                    for (int bj = 0; bj < 2; ++bj) { u32x4 w;
#pragma unroll
                        for (int n = 0; n < 2; ++n) { const pg8::f32x4 x1 = xv[mm][bj][n] + gv[bj][n] * acc[ai][bj][m][n];
                            *(pg8::f32x4*)(o + off + bj * 128 + 4 * n) = x1;
                            ss += x1[0] * x1[0] + x1[1] * x1[1] + x1[2] * x1[2] + x1[3] * x1[3];
                            const pg8::f32x4 y = x1 * wv[bj][n];
                            if (n == 0) { w.x = pack2(y[0], y[1]); w.y = pack2(y[2], y[3]); } else { w.z = pack2(y[0], y[1]); w.w = pack2(y[2], y[3]); } }
                        *(u32x4*)(an + off + bj * 128) = w; }
                    ss += __shfl_xor(ss, 16); ss += __shfl_xor(ss, 32);
                    if (fq == 0) atomicAdd(rs + row, ss); }
                asm volatile("" ::: "memory");
            }
    }
};

struct EpiNull { static constexpr bool PERM = true, AFTER_DRAIN = false; float* sink;
    __device__ __forceinline__ void operator()(const pg8::f32x4 (&acc)[2][2][4][2], const pg8::Unit& u, int wr, int wc, int fr, int fq) const { if (acc[0][0][0][0][0] == 1.2345e37f) sink[0] = 1.f; } };
struct QKVOrder {
    int G, c;
    __device__ __forceinline__ bool next(int i, pg8::Unit& u) const {
        const int L = i * G + c;
        if (L < 144) { u.pm = L / 3; u.pn = L % 3; return true; }
        const int L2 = L - 144; if (L2 >= 208) return false;
        u.pm = 48 + (L2 >> 2); u.pn = 3 + (L2 & 3); return true;
    }
    __device__ __forceinline__ void a_ready(const pg8::Unit&) const {}
    __device__ __forceinline__ void done(const pg8::Unit&) const {}
};
struct EpiQKV {
    static constexpr bool PERM = true, AFTER_DRAIN = false;
    bf16_t* QR; bf16_t* KVR;
    __device__ __forceinline__ void operator()(const pg8::f32x4 (&acc)[2][2][4][2], const pg8::Unit& u, int wr, int wc, int fr, int fq) const {
        const bool isq = u.pn < 3;
        const int ldc = isq ? 768 : 1024;
        bf16_t* base = isq ? QR + (size_t)(u.pm * 256) * 768 + u.pn * 256 : KVR + (size_t)((u.pm - 48) * 256) * 1024 + (u.pn - 3) * 256;
        const int rowl = wr * 64 + fr, col0 = wc * 32 + 8 * fq;
#pragma unroll
        for (int ai = 0; ai < 2; ++ai)
#pragma unroll
            for (int m = 0; m < 4; ++m) { bf16_t* rowp = base + (size_t)(rowl + ai * 128 + m * 16) * ldc + col0;
#pragma unroll
                for (int bj = 0; bj < 2; ++bj) { const pg8::f32x4 v0 = acc[ai][bj][m][0], v1 = acc[ai][bj][m][1];
                    u32x4 w; w.x = pack2(v0[0], v0[1]); w.y = pack2(v0[2], v0[3]); w.z = pack2(v1[0], v1[1]); w.w = pack2(v1[2], v1[3]);
                    *(u32x4*)(rowp + bj * 128) = w; } }
    }
};
template <class Epi> DI void run_gemm(const Params& p, LAS unsigned char* lds, const bf16_t* A, const bf16_t* Bt, int M, int N, int K, const Epi& E, int tx, bool rev = false) {
    pg8::Gemm g{A, Bt, M, N, K}; pg8::StaticOrder S; S.init(M, N, p.gx, rev ? p.gx - 1 - p.bx : p.bx);
    pg8::gemm_phase<Epi, pg8::StaticOrder, false>(lds, g, S, E, nullptr, tx);
}

__global__ void __launch_bounds__(NT, 2) fwd_megakernel(KParams pk) {
    extern __shared__ __attribute__((aligned(16))) unsigned char shm[];
    LAS unsigned char* lds = (LAS unsigned char*)shm;
    cg::grid_group grid = cg::this_grid();
    const int wv64 = __builtin_amdgcn_readfirstlane((int)threadIdx.x >> 6) * 64;
    if (threadIdx.x < 4) ((LAS unsigned*)(lds + LDS_STAGE))[threadIdx.x] = 0u;
    __syncthreads();
    XcdBarrier bar = xcd_barrier_post((unsigned*)(pk.ws + WS_BAR), (volatile LAS unsigned*)(lds + LDS_STAGE));
    if (pk.ph_lo < 0) grid.sync();
    for (int pass = (PREFIX > 0 ? 0 : 1); pass < 2; ++pass) {
    const int ph_end = (pass == 0) ? PREFIX : pk.ph_hi;
    for (int ph = pk.ph_lo; ph < ph_end; ++ph) {
        unsigned zl = 0u; size_t zo = 0; asm volatile("" : "+v"(zl), "+s"(zo));
        int tx = wv64 + (int)__builtin_amdgcn_mbcnt_hi(~0u, __builtin_amdgcn_mbcnt_lo(~0u, zl));
        Params p; p.out = pk.out + zo; p.ws = pk.ws + zo; { int bx_ = (int)blockIdx.x, gx_ = (int)gridDim.x; asm volatile("" : "+s"(bx_), "+s"(gx_)); p.bx = bx_; p.gx = gx_; }
#pragma unroll
        for (int i = 0; i < 34; ++i) p.in[i] = pk.in[i] + zo;
        unsigned char* ws = p.ws;
        if (ph == 0) { phase_zero_rs(p, tx); REP(0, phase_mod(p, lds, tx, 0, p.bx, p.gx)); REP(1, phase_convert(p, 0, lds, tx, p.gx - 1 - p.bx, p.gx, 0, 8 * 28)); }
        else {
            const int l = (ph <= 10) ? 0 : 1, idx = (l == 0) ? ph - 1 : ph - 11;
            const int k = (l == 0) ? (idx < 8 ? idx : idx + 1) : (idx < 7 ? idx + 1 : idx + 2);
            const float* modl = (const float*)(ws + WS_MOD) + (size_t)l * 5 * 6144;
            const unsigned char* wt = ws + (l ? WS_WT2 : 0);
            const float* xa = (l == 0) ? p.in[I_XP] : p.out; const float* xb = (l == 0) ? p.in[I_XS] : p.out + (size_t)TC * D;
            float* rsb = (float*)(ws + WS_RS); const float* wtab = (const float*)(ws + WS_WTAB);
            switch (k) {
            case 0: REP(2, phase_prep0(p, xa, xb, p.in[I_N1G], modl, 1024, tx)); phase_tables(p, tx, 0); phase_bias(p, 0, p.bx, p.gx, tx, 1); break;
            case 1: { EpiIn E{(bf16_t*)(ws + WS_R1), rsb + (size_t)(2 * l) * T, (const float*)(ws + WS_BIN) + (size_t)l * 5 * INWP}; REP(10, run_gemm(p, lds, (const bf16_t*)(ws + WS_R2), (const bf16_t*)(wt + WS_WT_IN), T, INWP, 1024, E, tx));
                      if (l == 0) { const bool big = p.gx > 160;
                        if (!big || p.bx >= 80) { FRESH_TX(txc); phase_convert(p, 0, lds, txc, big ? p.bx - 80 : p.bx, big ? p.gx - 80 : p.gx, 8 * 28); } } } break;
            case 2: if (!(pass == 0 && PFLAG == 2)) { REP(3, phase_post_in(p, l, tx)); } if (!(pass == 0 && PFLAG == 1)) { REP(9, phase_gates(p, l, lds, tx)); }
                    if (l == 0) { FRESH_TX(txb2); phase_bias(p, 0, p.bx, p.gx, txb2, 2); } break;
            case 3: {
                REP(4, phase_scan(p, l, lds, tx));
                int k256 = 256; asm volatile("" : "+s"(k256));
                { FRESH_TX(txa); EpiQKV E{(bf16_t*)(ws + WS_R3), (bf16_t*)(ws + WS_KVRAW)}; pg8::Gemm g{(const bf16_t*)(ws + WS_R4), (const bf16_t*)(wt + WS_WT_QUP), T + TKV, INWP, k256};
                  QKVOrder S{p.gx, p.gx - 1 - p.bx}; pg8::gemm_phase<EpiQKV, QKVOrder, false>(lds, g, S, E, nullptr, txa); }
            } break;
            case 4: REP(5, phase_qk_finalize(p, l, lds, tx)); break;
            case 5: REP(6, phase_attn(p, l, lds, tx)); break;
            case 6: if ((RMASK >> 14) & 1) { phase_mix_finalize(p, l, tx, 0, T / 2); xcd_barrier(bar); phase_mix_finalize(p, l, tx, T / 2, T); } else { REP(7, phase_mix_finalize(p, l, tx)); } break;
            case 7: { if ((RMASK >> 16) & 1) { FRESH_TX(txn); EpiNull EN{(float*)(ws + WS_BAR + 8192)}; run_gemm(p, lds, (const bf16_t*)(ws + WS_R2), (const bf16_t*)(wt + WS_WT_OUT), T, 1024, 1024, EN, txn); }
                      EpiResGateN E{xa, xb, p.out, modl + 2048, (bf16_t*)(ws + WS_R3), wtab + (size_t)((l * 2 + 1) * 5) * 1024, rsb + (size_t)(2 * l + 1) * T};
                      run_gemm(p, lds, (const bf16_t*)(ws + WS_R2), (const bf16_t*)(wt + WS_WT_OUT), T, 1024, 1024, E, tx);
                      if (l == 0) { const bool big = p.gx > 224; if (!big || p.bx >= 192) { FRESH_TX(txm); phase_mod(p, lds, txm, 1, big ? p.bx - 192 : p.bx, big ? p.gx - 192 : p.gx); } } } break;
            case 9: { EpiSwiGLU2 E{(bf16_t*)(ws + WS_R1), rsb + (size_t)(2 * l + 1) * T, (const float*)(ws + WS_BGU) + (size_t)l * 5 * 2 * FF};
                      REP(11, run_gemm(p, lds, (const bf16_t*)(ws + WS_R3), (const bf16_t*)(wt + WS_WT_GU), T, 2 * FF, 1024, E, tx));
                      { const bool big = p.gx > 64;
                        if (l == 0 && (!big || p.bx >= 32)) { unsigned z2 = 0u; asm volatile("" : "+v"(z2)); const int tx2 = wv64 + (int)__builtin_amdgcn_mbcnt_hi(~0u, __builtin_amdgcn_mbcnt_lo(~0u, z2)); phase_convert(p, 1, lds, tx2, big ? p.bx - 32 : p.bx, big ? p.gx - 32 : p.gx); }
                        if (l == 0) { FRESH_TX(txt); phase_tables(p, txt, 1); } } } break;
            case 10:
                if ((RMASK >> 15) & 1) { FRESH_TX(txn); EpiNull EN{(float*)(ws + WS_BAR + 8192)}; run_gemm(p, lds, (const bf16_t*)(ws + WS_R1), (const bf16_t*)(wt + WS_WT_DN), T, 1024, FF, EN, txn); }
                if (l == 0) { EpiResGateN E{p.out, p.out + (size_t)TC * D, p.out, modl + 5120, (bf16_t*)(ws + WS_R2), wtab + (size_t)((1 * 2 + 0) * 5) * 1024, rsb + (size_t)2 * T};
                      run_gemm(p, lds, (const bf16_t*)(ws + WS_R1), (const bf16_t*)(wt + WS_WT_DN), T, 1024, FF, E, tx);
                      { const bool big = p.gx > 224; if (!big || p.bx >= 192) { unsigned z2 = 0u; asm volatile("" : "+v"(z2)); const int tx2 = wv64 + (int)__builtin_amdgcn_mbcnt_hi(~0u, __builtin_amdgcn_mbcnt_lo(~0u, z2)); phase_bias(p, 1, big ? p.bx - 192 : p.bx, big ? p.gx - 192 : p.gx, tx2); } } }
                else { EpiResGate E{p.out, p.out + (size_t)TC * D, p.out, modl + 5120}; run_gemm(p, lds, (const bf16_t*)(ws + WS_R1), (const bf16_t*)(wt + WS_WT_DN), T, 1024, FF, E, tx); }
                break;
            }
        }
        if (ph + 1 < pk.ph_hi || pass == 0) { xcd_barrier(bar); if ((RMASK >> 12) & 1) xcd_barrier(bar); }
    }
    }
}

extern "C" void kernel_launch(void* const* d_in, const int* in_sizes, int n_in, void* d_out, int out_size, void* d_ws, size_t ws_size, hipStream_t stream) {
    static int grid_blocks = 0;
    if (!grid_blocks) {
        int dev = 0, cus = 0, per_cu = 0;
        hipGetDevice(&dev);
        hipDeviceGetAttribute(&cus, hipDeviceAttributeMultiprocessorCount, dev);
        hipFuncSetAttribute((const void*)fwd_megakernel, hipFuncAttributeMaxDynamicSharedMemorySize, LDS_BYTES);
        hipOccupancyMaxActiveBlocksPerMultiprocessor(&per_cu, (const void*)fwd_megakernel, NT, LDS_BYTES);
        if (per_cu < 1) per_cu = 1;
        if (per_cu > 1) per_cu = 1;
        grid_blocks = cus * per_cu;
        if (ws_size < WS_TOTAL) fprintf(stderr, "kernel_launch: workspace too small: %zu < %zu\n", ws_size, (size_t)WS_END);
    }
    if (hipMemsetAsync((unsigned char*)d_ws + WS_BAR, 0, 16384, stream) != hipSuccess) fprintf(stderr, "memset failed\n");
    KParams p{};
    for (int i = 0; i < 34; ++i) p.in[i] = (const float*)d_in[i];
    p.out = (float*)d_out; p.ws = (unsigned char*)d_ws; p.ph_lo = 0; p.ph_hi = 20;
    void* args[] = {&p};
    hipError_t e = hipLaunchCooperativeKernel((const void*)fwd_megakernel, dim3(grid_blocks), dim3(NT), args, LDS_BYTES, stream);
    if (e != hipSuccess) fprintf(stderr, "cooperative launch failed: %s (grid %d)\n", hipGetErrorString(e), grid_blocks);
}
```

```cpp
#include <hip/hip_runtime.h>
#include <hip/hip_cooperative_groups.h>
#include <cstdio>
namespace cg = cooperative_groups;

namespace pg8 {
#define PG8_LAS __attribute__((address_space(3)))
typedef unsigned short bf16_t;
typedef short bf16x8 __attribute__((ext_vector_type(8)));
typedef float f32x4 __attribute__((ext_vector_type(4)));
typedef unsigned u32x4 __attribute__((ext_vector_type(4)));
constexpr int BM = 256, BK = 64, HALF = 128, HTB = HALF * BK * 2  , STAGE_BYTES = 8 * HTB, NXCD = 8, WGM = 8;

__host__ __device__ __forceinline__ int lds_byte(int r, int c) { const int st = (r >> 4) * 2 + (c >> 5), rr = r & 15, cc = c & 31, ob = rr * 64 + cc * 2; return st * 1024 + (ob ^ (((ob >> 9) & 1) << 5)); }
__host__ __device__ __forceinline__ void stage_rc(int b, int& R, int& C) { const int st = b / 1024, sb = b % 1024, swz = sb ^ (((sb >> 9) & 1) << 5); R = (st >> 1) * 16 + swz / 64; C = (st & 1) * 32 + (swz % 64) / 2; }
__host__ __device__ __forceinline__ int perm32(int rho) { const int n = rho >> 4, i = rho & 15; return 8 * (i >> 2) + 4 * n + (i & 3); }

struct Unit { int pm, pn; };
struct Gemm { const bf16_t* A; const bf16_t* Bt; int M, N, K; };

struct StaticOrder {
    int nM, nN, nwg, G, c;
    __host__ __device__ void init(int M, int N, int G_, int c_) { nM = M / BM; nN = N / BM; nwg = nM * nN; G = G_; c = c_; }
    __host__ __device__ bool next(int i, Unit& u) const {
        const long L = (long)i * G + c; if (L >= nwg) return false;
        int wgid = (int)L; { const int q = nwg / NXCD, r = nwg % NXCD, xcd = wgid % NXCD, off = wgid / NXCD; wgid = (xcd < r ? xcd * (q + 1) : r * (q + 1) + (xcd - r) * q) + off; }
        const int nig = WGM * nN, gid = wgid / nig, fm = gid * WGM, gsz = (nM - fm) < WGM ? (nM - fm) : WGM;
        u.pm = fm + ((wgid % nig) % gsz); u.pn = (wgid % nig) / gsz; return true;
    }
    __device__ __forceinline__ void a_ready(const Unit&) const {}
    __device__ __forceinline__ void done(const Unit&) const {}
};
__device__ __forceinline__ unsigned cvt_pk_bf16(float lo, float hi) { unsigned r; asm volatile("v_cvt_pk_bf16_f32 %0, %1, %2" : "=v"(r) : "v"(lo), "v"(hi)); return r; }
typedef float f32x2 __attribute__((ext_vector_type(2)));
__device__ __forceinline__ f32x2 gelu_pk(f32x2 v) {
    const f32x2 av = __builtin_elementwise_abs(v), d = av * 0.2316418882f + 1.0f;
    f32x2 t; t.x = __builtin_amdgcn_rcpf(d.x); t.y = __builtin_amdgcn_rcpf(d.y);
    f32x2 q = t * 0.5307027145f + (-0.7265760135f); q = q * t + 0.7107068705f; q = q * t + (-0.142248368f); q = q * t + 0.127414796f; q = q * t;
    const f32x2 s = (v * v) * (-0.72134752044f);
    f32x2 e; e.x = __builtin_amdgcn_exp2f(s.x); e.y = __builtin_amdgcn_exp2f(s.y);
    const f32x2 m = v * (q * e), r = v - m;
    f32x2 o; o.x = v.x < 0.f ? m.x : r.x; o.y = v.y < 0.f ? m.y : r.y; return o;
}
template <int ACT  > struct EpiBf16 {
    static constexpr bool PERM = true, AFTER_DRAIN = false;
    bf16_t* O; int ldc; const float* bias; int split_cols; size_t split_stride;
    __device__ __forceinline__ void operator()(const f32x4 (&acc)[2][2][4][2], const Unit& u, int wr, int wc, int fr, int fq) const {
        const int row0 = u.pm * BM + wr * 64 + fr; int colt = u.pn * BM; bf16_t* base = O;
        if (split_cols) { const int t = colt / split_cols; base += (size_t)t * split_stride; colt -= t * split_cols; }
        const int col0 = colt + wc * 32 + 8 * fq, bcol0 = u.pn * BM + wc * 32 + 8 * fq;
        f32x4 bv[2][2];
#pragma unroll
        for (int bj = 0; bj < 2; ++bj)
#pragma unroll
            for (int n = 0; n < 2; ++n) bv[bj][n] = bias ? *(const f32x4*)(bias + bcol0 + bj * HALF + 4 * n) : (f32x4){0.f, 0.f, 0.f, 0.f};
#pragma unroll
        for (int ai = 0; ai < 2; ++ai)
#pragma unroll
            for (int m = 0; m < 4; ++m) { bf16_t* rowp = base + (size_t)(row0 + ai * HALF + m * 16) * ldc + col0;
#pragma unroll
                for (int bj = 0; bj < 2; ++bj) { f32x4 v0 = acc[ai][bj][m][0] + bv[bj][0], v1 = acc[ai][bj][m][1] + bv[bj][1];
                    if (ACT == 1) { f32x2 a = gelu_pk((f32x2){v0[0], v0[1]}), b = gelu_pk((f32x2){v0[2], v0[3]}), c = gelu_pk((f32x2){v1[0], v1[1]}), d = gelu_pk((f32x2){v1[2], v1[3]});
                        v0 = (f32x4){a.x, a.y, b.x, b.y}; v1 = (f32x4){c.x, c.y, d.x, d.y}; }
                    if (ACT == 2) {
#pragma unroll
                        for (int j = 0; j < 4; ++j) { v0[j] = 0.5f * v0[j] * (1.0f + erff(v0[j] * 0.70710678f)); v1[j] = 0.5f * v1[j] * (1.0f + erff(v1[j] * 0.70710678f)); } }
                    u32x4 w; w.x = cvt_pk_bf16(v0[0], v0[1]); w.y = cvt_pk_bf16(v0[2], v0[3]); w.z = cvt_pk_bf16(v1[0], v1[1]); w.w = cvt_pk_bf16(v1[2], v1[3]);
                    *(u32x4*)(rowp + bj * HALF) = w; } }
    }
};
template <class Epi, class Sched, bool STAMP = false>
__device__ __forceinline__ void gemm_phase(PG8_LAS unsigned char* lds, const Gemm g, const Sched& S, const Epi& E, unsigned long long* stamps, int tid_in) {
    const int tid = tid_in, wid = __builtin_amdgcn_readfirstlane(tid >> 6), lane = tid & 63, wr = wid >> 2, wc = wid & 3, fr = lane & 15, fq = lane >> 4;
    const int K = g.K, nt = K / BK;
    int ts_lo = 0, ts_hi = 0, nts = 0; const unsigned long long rt_entry = STAMP ? (unsigned long long)wall_clock64() : 0ull;
#define PG8_STAMP() do { if (STAMP && wid == 0 && nts < 64) { const unsigned long long _c = (unsigned long long)clock64(); \
        ts_lo = (lane == nts) ? (int)(unsigned)_c : ts_lo; ts_hi = (lane == nts) ? (int)(unsigned)(_c >> 32) : ts_hi; ++nts; } } while (0)
    PG8_STAMP();
    unsigned voffA[2], voffB[2];
#pragma unroll
    for (int i = 0; i < 2; ++i) { int R, C; stage_rc(tid * 16 + i * 8192, R, C); const int Rb = Epi::PERM ? ((R & ~31) + perm32(R & 31)) : R;
        voffA[i] = (unsigned)(R * K + C) * 2u; voffB[i] = (unsigned)(Rb * K + C) * 2u; }
    const size_t kstep = (size_t)(BK * 2);
    const size_t hstep = (size_t)HALF * K * 2;
    const size_t tstep = 2 * hstep;
    const unsigned ldsw = (unsigned)wid * 1024u;
    const int aoff = lds_byte(wr * 64 + fr, fq * 8), boff = lds_byte(wc * 32 + fr, fq * 8);
#define PG8_SA(b, h) (((b) * 2 + (h)) * HTB)
#define PG8_SB(b, h) ((4 + (b) * 2 + (h)) * HTB)
#define PG8_STAGE(bufoff, gbase, voff) do { _Pragma("unroll") for (int _i = 0; _i < 2; ++_i) \
        __builtin_amdgcn_global_load_lds((const unsigned*)((const char*)(gbase) + (voff)[_i]), (PG8_LAS unsigned*)(lds + (bufoff) + ldsw + _i * 8192), 16, 0, 0); } while (0)
#define PG8_LDA(dst, b, h) do { _Pragma("unroll") for (int m = 0; m < 4; ++m) _Pragma("unroll") for (int k = 0; k < 2; ++k) dst[m][k] = *(const PG8_LAS bf16x8*)(lds + PG8_SA(b, h) + aoff + m * 2048 + k * 1024); } while (0)
#define PG8_LDB(dst, b, h) do { _Pragma("unroll") for (int n = 0; n < 2; ++n) _Pragma("unroll") for (int k = 0; k < 2; ++k) dst[n][k] = *(const PG8_LAS bf16x8*)(lds + PG8_SB(b, h) + boff + n * 2048 + k * 1024); } while (0)
#define PG8_MMA(ai, bj, At, Bt) do { __builtin_amdgcn_s_setprio(1); _Pragma("unroll") for (int m = 0; m < 4; ++m) _Pragma("unroll") for (int n = 0; n < 2; ++n) _Pragma("unroll") for (int k = 0; k < 2; ++k) \
        acc[ai][bj][m][n] = __builtin_amdgcn_mfma_f32_16x16x32_bf16(Bt[n][k], At[m][k], acc[ai][bj][m][n], 0, 0, 0); __builtin_amdgcn_s_setprio(0); } while (0)
#define PG8_WAIT_V(n) asm volatile("s_waitcnt vmcnt(" #n ")" ::: "memory")
#define PG8_WAIT_L(n) asm volatile("s_waitcnt lgkmcnt(" #n ")" ::: "memory")
#define PG8_BAR __builtin_amdgcn_s_barrier()
#define PG8_SCHED __builtin_amdgcn_sched_barrier(0)
    Unit cur, nxt; int ui = 0;
    if (!S.next(0, cur)) return;
    f32x4 acc[2][2][4][2];
#pragma unroll
    for (int a = 0; a < 2; ++a)
#pragma unroll
        for (int b = 0; b < 2; ++b)
#pragma unroll
            for (int m = 0; m < 4; ++m)
#pragma unroll
                for (int n = 0; n < 2; ++n) acc[a][b][m][n] = (f32x4){0.f, 0.f, 0.f, 0.f};
    bf16x8 At[4][2], B0[2][2], B1[2][2];
    const char* cA = (const char*)g.A + (size_t)cur.pm * tstep; const char* cB = (const char*)g.Bt + (size_t)cur.pn * tstep;
    S.a_ready(cur);
    PG8_STAGE(PG8_SB(0, 0), cB, voffB); PG8_STAGE(PG8_SA(0, 0), cA, voffA); PG8_STAGE(PG8_SB(0, 1), cB + hstep, voffB); PG8_STAGE(PG8_SA(0, 1), cA + hstep, voffA);
    if (wr == 1) PG8_BAR;
    PG8_WAIT_V(4); PG8_BAR;
    PG8_STAGE(PG8_SB(1, 0), cB + kstep, voffB); PG8_STAGE(PG8_SA(1, 0), cA + kstep, voffA); PG8_STAGE(PG8_SB(1, 1), cB + hstep + kstep, voffB);
    PG8_WAIT_V(6); PG8_BAR;
    PG8_STAMP();
    for (;;) {
        const bool has_next = S.next(ui + 1, nxt);
        const char* nA = has_next ? (const char*)g.A + (size_t)nxt.pm * tstep : cA; const char* nB = has_next ? (const char*)g.Bt + (size_t)nxt.pn * tstep : cB;
        for (int t = 0; t < nt; t += 2) {
            const bool last = (t == nt - 2);
            const char* a1 = cA + (size_t)(t + 1) * kstep;
            const char* a2 = last ? nA : cA + (size_t)(t + 2) * kstep; const char* b2 = last ? nB : cB + (size_t)(t + 2) * kstep;
            const char* a3 = a2 + kstep; const char* b3 = b2 + kstep;
            if (last && has_next) S.a_ready(nxt);
            PG8_LDB(B0, 0, 0); PG8_SCHED; PG8_LDA(At, 0, 0); PG8_STAGE(PG8_SA(1, 1), a1 + hstep, voffA);
            PG8_WAIT_L(8); PG8_BAR; PG8_WAIT_L(0); PG8_MMA(0, 0, At, B0); PG8_BAR; PG8_SCHED;
            PG8_LDB(B1, 0, 1); PG8_STAGE(PG8_SB(0, 0), b2, voffB);
            PG8_BAR; PG8_WAIT_L(0); PG8_MMA(0, 1, At, B1); PG8_BAR;
            PG8_LDA(At, 0, 1); PG8_STAGE(PG8_SA(0, 0), a2, voffA);
            PG8_BAR; PG8_WAIT_L(0); PG8_MMA(1, 0, At, B0); PG8_BAR; PG8_SCHED;
            PG8_STAGE(PG8_SB(0, 1), b2 + hstep, voffB);
            PG8_WAIT_V(6); PG8_BAR; PG8_MMA(1, 1, At, B1); PG8_BAR;
            PG8_LDB(B0, 1, 0); PG8_SCHED; PG8_LDA(At, 1, 0); PG8_STAGE(PG8_SA(0, 1), a2 + hstep, voffA);
            PG8_WAIT_L(8); PG8_BAR; PG8_WAIT_L(0); PG8_MMA(0, 0, At, B0); PG8_BAR; PG8_SCHED;
            PG8_LDB(B1, 1, 1); PG8_STAGE(PG8_SB(1, 0), b3, voffB);
            PG8_BAR; PG8_WAIT_L(0); PG8_MMA(0, 1, At, B1); PG8_BAR;
            PG8_LDA(At, 1, 1); PG8_STAGE(PG8_SA(1, 0), a3, voffA);
            PG8_BAR; PG8_WAIT_L(0); PG8_MMA(1, 0, At, B0); PG8_BAR; PG8_SCHED;
            PG8_STAGE(PG8_SB(1, 1), b3 + hstep, voffB);
            PG8_WAIT_V(6); PG8_BAR; PG8_MMA(1, 1, At, B1); PG8_BAR;
        }
        PG8_STAMP();
        if constexpr (!Epi::AFTER_DRAIN) { unsigned zl_ = 0u; asm volatile("" : "+v"(zl_)); const int l2_ = (int)__builtin_amdgcn_mbcnt_hi(~0u, __builtin_amdgcn_mbcnt_lo(~0u, zl_));
            E(acc, cur, wr, wc, l2_ & 15, l2_ >> 4); S.done(cur); }
        PG8_STAMP();
        if (!has_next) break;
#pragma unroll
        for (int a = 0; a < 2; ++a)
#pragma unroll
            for (int b = 0; b < 2; ++b)
#pragma unroll
                for (int m = 0; m < 4; ++m)
#pragma unroll
                    for (int n = 0; n < 2; ++n) acc[a][b][m][n] = (f32x4){0.f, 0.f, 0.f, 0.f};
        cur = nxt; cA = nA; cB = nB; ++ui;
    }
    PG8_WAIT_V(0);
    if (wr == 0) PG8_BAR;
    PG8_BAR;
    if constexpr (Epi::AFTER_DRAIN) { E.fused(acc, cur, wr, wc, fr, fq, lds, wid, lane); S.done(cur); }
    PG8_STAMP();
    if (STAMP && wid == 0) { stamps[lane] = lane < nts ? (((unsigned long long)(unsigned)ts_hi << 32) | (unsigned)ts_lo) : 0ull;
        if (lane == 62) stamps[62] = rt_entry; if (lane == 63) stamps[63] = (unsigned long long)wall_clock64(); }
#undef PG8_STAMP
#undef PG8_SA
#undef PG8_SB
#undef PG8_STAGE
#undef PG8_LDA
#undef PG8_LDB
#undef PG8_MMA
#undef PG8_WAIT_V
#undef PG8_WAIT_L
#undef PG8_BAR
#undef PG8_SCHED
}
}

#define DI __device__ __forceinline__
#define LAS __attribute__((address_space(3)))
typedef unsigned short bf16_t;
typedef short bf16x8 __attribute__((ext_vector_type(8)));
typedef short s16x4 __attribute__((ext_vector_type(4)));
typedef float f32x4 __attribute__((ext_vector_type(4)));
typedef float f32x16 __attribute__((ext_vector_type(16)));
typedef unsigned u32x4 __attribute__((ext_vector_type(4)));
typedef unsigned u32x2 __attribute__((ext_vector_type(2)));

#ifndef PREFIX
#define PREFIX 0
#endif
#ifndef PFLAG
#define PFLAG 0
#endif
#ifndef RMASK
#define RMASK 0
#endif
#define FRESH_TX(name) unsigned name##_z = 0u; asm volatile("" : "+v"(name##_z)); const int name = wv64 + (int)__builtin_amdgcn_mbcnt_hi(~0u, __builtin_amdgcn_mbcnt_lo(~0u, name##_z))
#define REP(bit, ...) do { __VA_ARGS__; if ((RMASK >> (bit)) & 1) { __syncthreads(); __VA_ARGS__; } } while (0)
constexpr int NT = 512;
constexpr int D = 1024, TC = 8192, TLAT = 4096, T = TC + TLAT, TKV = T + 1024;
constexpr int INW = 1696, INWP = 1792, FF = 2816;
constexpr int LDS_STAGE = 131072, LDS_BYTES = LDS_STAGE + 16;
constexpr float EPS = 1e-6f;
constexpr float QSCALE = 0.10206207261596577f * 1.4426950408889634f;

constexpr size_t WS_WT_IN = 0;
constexpr size_t WS_WT_QUP = WS_WT_IN + (size_t)INWP * 1024 * 2;
constexpr size_t WS_WT_KVUP = WS_WT_QUP + (size_t)768 * 256 * 2;
constexpr size_t WS_WT_OUT = WS_WT_KVUP + (size_t)1024 * 256 * 2;
constexpr size_t WS_WT_GU = WS_WT_OUT + (size_t)1024 * 1024 * 2;
constexpr size_t WS_WT_DN = WS_WT_GU + (size_t)2 * FF * 1024 * 2;
constexpr size_t WS_MOD = WS_WT_DN + (size_t)1024 * FF * 2;
constexpr size_t WS_R1 = WS_MOD + (size_t)2 * 5 * 6144 * 4;
constexpr size_t WS_XC = WS_R1 + (size_t)T * INWP * 2;
constexpr size_t WS_R2 = WS_R1 + (size_t)T * FF * 2;
constexpr size_t WS_R3 = WS_R2 + (size_t)T * 1024 * 2;
constexpr size_t WS_KVRAW = WS_R3 + (size_t)T * 768 * 2;
constexpr size_t WS_R4 = WS_KVRAW + (size_t)TKV * 1024 * 2;
constexpr size_t WS_CKV = WS_R4 + (size_t)T * 256 * 2;
constexpr size_t WS_K = WS_R4 + (size_t)T * 768 * 2;
constexpr size_t WS_VT = WS_K + (size_t)TKV * 768 * 2;
constexpr size_t WS_HF = WS_VT + (size_t)TKV * 512 * 2;
constexpr size_t WS_END = WS_HF + (size_t)2 * T * 256 * 4;
constexpr size_t WS_BAR = WS_END;
constexpr size_t WS_WT2 = WS_BAR + 16384;
constexpr size_t WS_RS = WS_WT2 + WS_MOD;
constexpr size_t WS_BIN = WS_RS + (size_t)4 * T * 4;
constexpr size_t WS_BGU = WS_BIN + (size_t)2 * 5 * INWP * 4;
constexpr size_t WS_WTAB = WS_BGU + (size_t)2 * 5 * 2 * FF * 4;
constexpr size_t WS_TOTAL = WS_WTAB + (size_t)2 * 2 * 5 * 1024 * 4;
static_assert(WS_TOTAL <= (size_t)256 * 1024 * 1024, "workspace too large");
static_assert((size_t)T * 256 * 2 + (size_t)TKV * 256 * 2 <= (size_t)T * 768 * 2, "QLAT+CKV must fit in Q region");

constexpr size_t OUT_CKV = (size_t)T * 1024, OUT_KR = OUT_CKV + (size_t)32 * 2 * 256 * 128, OUT_ST = OUT_KR + (size_t)32 * 2 * 256 * 32;

struct KParams { const float* in[34]; float* out; unsigned char* ws; int ph_lo, ph_hi; };
struct Params { const float* in[34]; float* out; unsigned char* ws; int bx, gx; };
enum { I_XP = 0, I_XS, I_CCKV, I_CKR, I_STATE, I_C, I_CCTX, I_N1G, I_ADAW, I_ADAB, I_WIN, I_CONVW, I_CONVB, I_LCW, I_LCB, I_LWA, I_LBA, I_LWI, I_LBI, I_LAM,
       I_QNG, I_WQUP, I_KVNG, I_WKVUP, I_QHG, I_KHG, I_GNC, I_GNL, I_GNM, I_WOUT, I_N2G, I_WG, I_WU, I_WD };

DI unsigned pack2(float lo, float hi) {
    typedef __bf16 bf2 __attribute__((ext_vector_type(2))); typedef float f2 __attribute__((ext_vector_type(2)));
    f2 v = {lo, hi}; bf2 b = __builtin_convertvector(v, bf2); return __builtin_bit_cast(unsigned, b);
}
DI float bf2f(unsigned short b) { return __uint_as_float(((unsigned)b) << 16); }
DI float bflo(unsigned w) { return __uint_as_float(w << 16); }
DI float bfhi(unsigned w) { return __uint_as_float(w & 0xffff0000u); }
DI float wave_sum(float v) {
#pragma unroll
    for (int o = 32; o >= 1; o >>= 1) v += __shfl_xor(v, o);
    return v;
}
#define MFMA32(a, b, c) __builtin_amdgcn_mfma_f32_32x32x16_bf16((a), (b), (c), 0, 0, 0)
DI float sigmoidf_(float x) { return 1.0f / (1.0f + __expf(-x)); }

DI void phase_mod(const Params& p, LAS unsigned char* lds, int tx, int lsel, int first, int nblk) {
    const int tid = tx;
    LAS float* sc = (LAS float*)lds;
    LAS float* red = (LAS float*)(lds + 20480);
    for (int i = tid; i < 5 * 1024; i += NT) { const int ci = i >> 10, k = i & 1023; const float v = (ci == 0) ? p.in[I_CCTX][k] : p.in[I_C][(ci - 1) * 1024 + k]; sc[i] = v / (1.0f + __expf(-v)); }
    __syncthreads();
    float* mod = (float*)(p.ws + WS_MOD);
    const int cg = tid & 15, kg = tid >> 4;
    for (int unit = first; unit < 96; unit += nblk) {
        const int l = lsel, n0 = unit * 64;
        const float* w = p.in[I_ADAW] + (size_t)l * 1024 * 6144 + n0 + 4 * cg;
        f32x4 a0 = {0.f, 0.f, 0.f, 0.f}, a1 = a0, a2 = a0, a3 = a0, a4 = a0;
#pragma unroll 8
        for (int k = kg * 32; k < kg * 32 + 32; ++k) { const f32x4 wv = *(const f32x4*)(w + (size_t)k * 6144); a0 += sc[k] * wv; a1 += sc[1024 + k] * wv; a2 += sc[2048 + k] * wv; a3 += sc[3072 + k] * wv; a4 += sc[4096 + k] * wv; }
#pragma unroll
        for (int q = 0; q < 4; ++q) { LAS float* r = red + (kg * 64 + 4 * cg + q) * 5; r[0] = a0[q]; r[1] = a1[q]; r[2] = a2[q]; r[3] = a3[q]; r[4] = a4[q]; }
        __syncthreads();
        if (tid < 320) { const int c = tid >> 6, c2 = tid & 63; float sum = 0.f;
#pragma unroll
            for (int g = 0; g < 32; ++g) sum += red[(g * 64 + c2) * 5 + c];
            mod[(size_t)(l * 5 + c) * 6144 + n0 + c2] = sum + p.in[I_ADAB][l * 6144 + n0 + c2]; }
        __syncthreads();
    }
}

DI void cvt_tile(const float* __restrict__ src, bf16_t* __restrict__ dst, int K, int N, int Kpad, int kt, int nt, int mode, LAS unsigned char* lds, int tx) {
    LAS float* tile = (LAS float*)lds;
    const int tid = tx, cx = tid & 63, ty = tid >> 6;
    float v[16];
#pragma unroll
    for (int i = 0; i < 16; ++i) { const int k = kt * 128 + ty + 8 * i, n = nt * 64 + cx; v[i] = (k < K && n < N) ? src[(size_t)k * N + n] : 0.f; }
#pragma unroll
    for (int i = 0; i < 16; ++i) tile[(ty + 8 * i) * 65 + cx] = v[i];
    __syncthreads();
#pragma unroll
    for (int it = 0; it < 2; ++it) {
        const int item = tid + 512 * it, nl = item >> 4, kc = (item & 15) * 8, n = nt * 64 + nl;
        u32x4 w;
        w.x = pack2(tile[(kc + 0) * 65 + nl], tile[(kc + 1) * 65 + nl]); w.y = pack2(tile[(kc + 2) * 65 + nl], tile[(kc + 3) * 65 + nl]);
        w.z = pack2(tile[(kc + 4) * 65 + nl], tile[(kc + 5) * 65 + nl]); w.w = pack2(tile[(kc + 6) * 65 + nl], tile[(kc + 7) * 65 + nl]);
        const int R = (mode == 0) ? n : (256 * (n >> 7) + 128 * (mode - 1) + (n & 127));
        *(u32x4*)(dst + (size_t)R * Kpad + kt * 128 + kc) = w;
    }
    __syncthreads();
}
DI void phase_convert(const Params& p, int l, LAS unsigned char* lds, int tx, int first, int nblk, int ulo = 0, int uhi = 1 << 30) {
    unsigned char* wsl = p.ws + (l ? WS_WT2 : 0);
    const int c0 = 8 * 28, c1 = c0 + 2 * 12, c2 = c1 + 2 * 16, c3 = c2 + 8 * 16, c4 = c3 + 8 * 44, c5 = c4 + 8 * 44, c6 = c5 + 22 * 16;
    for (int u = ulo + first; u < c6 && u < uhi; u += nblk) {
        if (u < c0)      { const int v = u;      cvt_tile(p.in[I_WIN] + (size_t)l * 1024 * INW, (bf16_t*)(wsl + WS_WT_IN), 1024, INW, 1024, v % 8, v / 8, 0, lds, tx); }
        else if (u < c1) { const int v = u - c0; cvt_tile(p.in[I_WQUP] + (size_t)l * 256 * 768, (bf16_t*)(wsl + WS_WT_QUP), 256, 768, 256, v % 2, v / 2, 0, lds, tx); }
        else if (u < c2) { const int v = u - c1; cvt_tile(p.in[I_WKVUP] + (size_t)l * 128 * 1024, (bf16_t*)(wsl + WS_WT_KVUP), 128, 1024, 256, v % 2, v / 2, 0, lds, tx); }
        else if (u < c3) { const int v = u - c2; cvt_tile(p.in[I_WOUT] + (size_t)l * 1024 * 1024, (bf16_t*)(wsl + WS_WT_OUT), 1024, 1024, 1024, v % 8, v / 8, 0, lds, tx); }
        else if (u < c4) { const int v = u - c3; cvt_tile(p.in[I_WG] + (size_t)l * 1024 * FF, (bf16_t*)(wsl + WS_WT_GU), 1024, FF, 1024, v % 8, v / 8, 1, lds, tx); }
        else if (u < c5) { const int v = u - c4; cvt_tile(p.in[I_WU] + (size_t)l * 1024 * FF, (bf16_t*)(wsl + WS_WT_GU), 1024, FF, 1024, v % 8, v / 8, 2, lds, tx); }
        else             { const int v = u - c5; cvt_tile(p.in[I_WD] + (size_t)l * FF * 1024, (bf16_t*)(wsl + WS_WT_DN), FF, 1024, FF, v % 22, v / 22, 0, lds, tx); }
    }
}

DI void phase_prep0(const Params& p, const float* __restrict__ xa, const float* __restrict__ xb, const float* __restrict__ g, const float* __restrict__ modl, int scoff, int tx) {
    const int lane = tx & 63, wave = tx >> 6;
    bf16_t* __restrict__ HN = (bf16_t*)(p.ws + WS_R2);
    float* __restrict__ rs = (float*)(p.ws + WS_RS);
    for (int rb = (p.bx * 8 + wave) * 3; rb < T; rb += p.gx * 8 * 3) {
        f32x4 v[3][4];
#pragma unroll
        for (int q = 0; q < 3; ++q) { const int r = rb + q; const float* x = (r < TC) ? xa + (size_t)r * D : xb + (size_t)(r - TC) * D;
#pragma unroll
            for (int i = 0; i < 4; ++i) v[q][i] = *(const f32x4*)(x + 4 * (lane + 64 * i)); }
#pragma unroll
        for (int q = 0; q < 3; ++q) { const int r = rb + q; const int ci = (r < TC) ? 0 : 1 + ((r - TC) >> 10);
            float ss = 0.f;
#pragma unroll
            for (int i = 0; i < 4; ++i) ss += v[q][i][0] * v[q][i][0] + v[q][i][1] * v[q][i][1] + v[q][i][2] * v[q][i][2] + v[q][i][3] * v[q][i][3];
            ss = wave_sum(ss);
            if (lane == 0) rs[r] = ss;
#pragma unroll
            for (int i = 0; i < 4; ++i) { const int col = 4 * (lane + 64 * i);
                const f32x4 gv = *(const f32x4*)(g + col), sc = *(const f32x4*)(modl + ci * 6144 + scoff + col);
                const f32x4 y = v[q][i] * (gv * (sc + 1.0f));
                u32x2 w; w.x = pack2(y[0], y[1]); w.y = pack2(y[2], y[3]);
                *(u32x2*)(HN + (size_t)r * D + col) = w; } }
    }
}
DI void phase_tables(const Params& p, int tx, int lsel) {
    float* wtab = (float*)(p.ws + WS_WTAB); const float* mod = (const float*)(p.ws + WS_MOD);
#pragma unroll
    for (int kq = 0; kq < 4; ++kq) { const int i = (kq * p.gx + p.bx) * NT + tx; if (i >= 2 * 2 * 5 * 1024) continue;
        const int col = i & 1023, ci = (i >> 10) % 5, which = ((i >> 10) / 5) & 1, l = (i >> 10) / 10; if (l != lsel) continue;
        const float g = (which ? p.in[I_N2G] : p.in[I_N1G])[l * 1024 + col];
        wtab[i] = g * (1.0f + mod[(size_t)(l * 5 + ci) * 6144 + (which ? 4096 : 1024) + col]);
    }
}
DI void phase_zero_rs(const Params& p, int tx) {
    float* rs = (float*)(p.ws + WS_RS) + T;
#pragma unroll
    for (int k = 0; k < 4; ++k) { const int i = (k * p.gx + p.bx) * NT + tx; if (i < 3 * T) rs[i] = 0.f; }
}
DI void bias_rows(const bf16_t* __restrict__ WT, const float* __restrict__ sh  , float* __restrict__ out, int N, int gw, int nw, int lane) {
    float sv[5][16];
#pragma unroll
    for (int ci = 0; ci < 5; ++ci)
#pragma unroll
        for (int i = 0; i < 4; ++i) { const f32x4 t = *(const f32x4*)(sh + ci * 6144 + lane * 16 + 4 * i); sv[ci][4 * i] = t[0]; sv[ci][4 * i + 1] = t[1]; sv[ci][4 * i + 2] = t[2]; sv[ci][4 * i + 3] = t[3]; }
    for (int n0 = gw * 4; n0 < N; n0 += nw * 4) {
        u32x4 w0[4], w1[4];
#pragma unroll
        for (int q = 0; q < 4; ++q) { w0[q] = *(const u32x4*)(WT + (size_t)(n0 + q) * 1024 + lane * 16); w1[q] = *(const u32x4*)(WT + (size_t)(n0 + q) * 1024 + lane * 16 + 8); }
#pragma unroll
        for (int q = 0; q < 4; ++q) {
            const float wf[16] = {bflo(w0[q].x), bfhi(w0[q].x), bflo(w0[q].y), bfhi(w0[q].y), bflo(w0[q].z), bfhi(w0[q].z), bflo(w0[q].w), bfhi(w0[q].w), bflo(w1[q].x), bfhi(w1[q].x), bflo(w1[q].y), bfhi(w1[q].y), bflo(w1[q].z), bfhi(w1[q].z), bflo(w1[q].w), bfhi(w1[q].w)};
            float d[5];
#pragma unroll
            for (int ci = 0; ci < 5; ++ci) { float a = 0.f;
#pragma unroll
                for (int i = 0; i < 16; ++i) a += sv[ci][i] * wf[i];
                d[ci] = a; }
#pragma unroll
            for (int o = 32; o >= 1; o >>= 1) { d[0] += __shfl_xor(d[0], o); d[1] += __shfl_xor(d[1], o); d[2] += __shfl_xor(d[2], o); d[3] += __shfl_xor(d[3], o); d[4] += __shfl_xor(d[4], o); }
            const float val = lane == 0 ? d[0] : lane == 1 ? d[1] : lane == 2 ? d[2] : lane == 3 ? d[3] : d[4];
            if (lane < 5) out[(size_t)lane * N + n0 + q] = val;
        }
    }
}
DI void phase_bias(const Params& p, int l, int first, int nblk, int tx, int parts = 3) {
    const int lane = tx & 63, wave = tx >> 6;
    const unsigned char* wt = p.ws + (l ? WS_WT2 : 0);
    const float* modl = (const float*)(p.ws + WS_MOD) + (size_t)l * 5 * 6144;
    if (parts & 1) bias_rows((const bf16_t*)(wt + WS_WT_IN), modl + 0, (float*)(p.ws + WS_BIN) + (size_t)l * 5 * INWP, INWP, first * 8 + wave, nblk * 8, lane);
    if (parts & 2) bias_rows((const bf16_t*)(wt + WS_WT_GU), modl + 3072, (float*)(p.ws + WS_BGU) + (size_t)l * 5 * 2 * FF, 2 * FF, first * 8 + wave, nblk * 8, lane);
}

DI void phase_post_in(const Params& p, int l, int tx) {
    const int lane = tx & 63, wave = tx >> 6;
    const bf16_t* __restrict__ U = (const bf16_t*)(p.ws + WS_R1);
    bf16_t* __restrict__ QLAT = (bf16_t*)(p.ws + WS_R4);
    bf16_t* __restrict__ CKV = (bf16_t*)(p.ws + WS_CKV);
    float* __restrict__ out = p.out;
    const f32x4 qgv = *(const f32x4*)(p.in[I_QNG] + l * 256 + 4 * lane);
    const float kg0 = p.in[I_KVNG][l * 128 + 2 * lane], kg1 = p.in[I_KVNG][l * 128 + 2 * lane + 1];
    for (int rb = (p.bx * 8 + wave) * 4; rb < T + 1024; rb += p.gx * 8 * 4) {
        if (rb < T) {
            u32x2 qw[4]; unsigned cw[4]; unsigned short kr[4];
#pragma unroll
            for (int q = 0; q < 4; ++q) { const bf16_t* u = U + (size_t)(rb + q) * INWP; qw[q] = *(const u32x2*)(u + 1280 + 4 * lane); cw[q] = *(const unsigned*)(u + 1536 + 2 * lane); kr[q] = u[1664 + (lane & 31)]; }
#pragma unroll
            for (int q = 0; q < 4; ++q) { const int r = rb + q;
                const float a = bflo(qw[q].x), b = bfhi(qw[q].x), c = bflo(qw[q].y), d = bfhi(qw[q].y), e = bflo(cw[q]), f = bfhi(cw[q]);
                float s1 = a * a + b * b + c * c + d * d, s2 = e * e + f * f;
#pragma unroll
                for (int o = 32; o >= 1; o >>= 1) { s1 += __shfl_xor(s1, o); s2 += __shfl_xor(s2, o); }
                const float i1 = rsqrtf(s1 * (1.0f / 256.0f) + EPS), i2 = rsqrtf(s2 * (1.0f / 128.0f) + EPS);
                u32x2 o; o.x = pack2(a * i1 * qgv[0], b * i1 * qgv[1]); o.y = pack2(c * i1 * qgv[2], d * i1 * qgv[3]);
                *(u32x2*)(QLAT + (size_t)r * 256 + 4 * lane) = o;
                const float y0 = e * i2 * kg0, y1 = f * i2 * kg1;
                *(unsigned*)(CKV + (size_t)r * 256 + 2 * lane) = pack2(y0, y1);
                *(unsigned*)(CKV + (size_t)r * 256 + 128 + 2 * lane) = 0u;
                if (r < TC) { const int b_ = r >> 8, sq = r & 255; typedef float f32x2_ __attribute__((ext_vector_type(2))); *(f32x2_*)(out + OUT_CKV + ((size_t)(b_ * 2 + l) * 256 + sq) * 128 + 2 * lane) = (f32x2_){y0, y1};
                    if (lane < 32) out[OUT_KR + ((size_t)(b_ * 2 + l) * 256 + sq) * 32 + lane] = bf2f(kr[q]); }
            }
        } else {
#pragma unroll
            for (int q = 0; q < 4; ++q) { const int r = rb + q, rc = r - T, b_ = rc >> 8, sq = rc & 255;
                const float* src = p.in[I_CCKV] + ((size_t)(b_ * 2 + l) * 256 + sq) * 128 + 2 * lane;
                *(unsigned*)(CKV + (size_t)r * 256 + 2 * lane) = pack2(src[0], src[1]);
                *(unsigned*)(CKV + (size_t)r * 256 + 128 + 2 * lane) = 0u; }
        }
    }
}

DI void gates_unit(const Params& p, int l, int tt128, int n, int dir, LAS unsigned char* lds, int tx, const bf16x8 (&wfa)[4], const bf16x8 (&wfi)[4], float ba, float bi, float sp) {
    const int tid = tx, lane = tid & 63, wave = tid >> 6, r32 = lane & 31, half = lane >> 5, tt = wave >> 1, jt = wave & 1;
    const bf16_t* __restrict__ U = (const bf16_t*)(p.ws + WS_R1);
    float* __restrict__ Ab = (float*)(p.ws + WS_R2) + (size_t)dir * T * 256;
    float* __restrict__ Bb = (float*)(p.ws + WS_XC) + (size_t)dir * T * 256;
    LAS float* xs = (LAS float*)lds;
    LAS unsigned char* xb = lds + 32768;
    const float* cw = p.in[I_LCW] + l * 4 * 256 + n * 64; const float* cb = p.in[I_LCB] + l * 256 + n * 64;
    const int r0 = tt128 * 128;
#pragma unroll
    for (int it = 0; it < 2; ++it) {
        const int item = tid + 512 * it, tl = item >> 3, cg = (item & 7) * 8, r = r0 + tl;
        const int s = (r < TC) ? (r & 255) : ((r - TC) & 1023), S = (r < TC) ? 256 : 1024;
        f32x4 a0 = *(const f32x4*)(cb + cg), a1 = *(const f32x4*)(cb + cg + 4);
#pragma unroll
        for (int k = 0; k < 4; ++k) { const int sk = s + k - 2;
            if (sk >= 0 && sk < S) { const u32x4 w = *(const u32x4*)(U + (size_t)(r + k - 2) * INWP + 768 + n * 64 + cg);
                const f32x4 w0 = *(const f32x4*)(cw + k * 256 + cg), w1 = *(const f32x4*)(cw + k * 256 + cg + 4);
                a0[0] += w0[0] * bflo(w.x); a0[1] += w0[1] * bfhi(w.x); a0[2] += w0[2] * bflo(w.y); a0[3] += w0[3] * bfhi(w.y);
                a1[0] += w1[0] * bflo(w.z); a1[1] += w1[1] * bfhi(w.z); a1[2] += w1[2] * bflo(w.w); a1[3] += w1[3] * bfhi(w.w); } }
        *(LAS f32x4*)(xs + tl * 64 + cg) = a0; *(LAS f32x4*)(xs + tl * 64 + cg + 4) = a1;
        u32x4 pw; pw.x = pack2(a0[0], a0[1]); pw.y = pack2(a0[2], a0[3]); pw.z = pack2(a1[0], a1[1]); pw.w = pack2(a1[2], a1[3]);
        *(LAS u32x4*)(xb + tl * 144 + cg * 2) = pw;
    }
    __syncthreads();
    f32x16 za, zi;
#pragma unroll
    for (int i = 0; i < 16; ++i) { za[i] = ba; zi[i] = bi; }
#pragma unroll
    for (int kk = 0; kk < 4; ++kk) {
        const bf16x8 af = *(const LAS bf16x8*)(xb + (tt * 32 + r32) * 144 + (kk * 16 + 8 * half) * 2);
        za = MFMA32(af, wfa[kk], za); zi = MFMA32(af, wfi[kk], zi);
    }
    const int c = n * 64 + jt * 32 + r32;
#pragma unroll
    for (int i = 0; i < 16; ++i) {
        const int tl = tt * 32 + (i & 3) + 8 * (i >> 2) + 4 * half, r = r0 + tl;
        const float xj = xs[tl * 64 + jt * 32 + r32];
        const float rr = __builtin_amdgcn_rcpf(1.0f + __builtin_amdgcn_exp2f(-1.4426950408889634f * za[i]));
        const float ii = __builtin_amdgcn_rcpf(1.0f + __builtin_amdgcn_exp2f(-1.4426950408889634f * zi[i]));
        const float la = -8.0f * rr * sp;
        const float a = __builtin_amdgcn_exp2f(1.4426950408889634f * la);
        const float bt = __builtin_amdgcn_sqrtf(-expm1f(2.0f * la)) * (ii * xj);
        Ab[(size_t)r * 256 + c] = a; Bb[(size_t)r * 256 + c] = bt;
    }
    __syncthreads();
}
DI void gates_load_w(const Params& p, int l, int n, int dir, int tx, bf16x8 (&wfa)[4], bf16x8 (&wfi)[4], float& ba, float& bi, float& sp) {
    const int lane = tx & 63, wave = tx >> 6, r32 = lane & 31, half = lane >> 5, jt = wave & 1, j = jt * 32 + r32;
    const float* wap = p.in[I_LWA] + ((size_t)((l * 2 + dir) * 4 + n) * 64) * 64 + j;
    const float* wip = p.in[I_LWI] + ((size_t)((l * 2 + dir) * 4 + n) * 64) * 64 + j;
#pragma unroll
    for (int kk = 0; kk < 4; ++kk) { u32x4 wa_, wi_; const int k0 = kk * 16 + 8 * half;
        wa_.x = pack2(wap[(k0 + 0) * 64], wap[(k0 + 1) * 64]); wa_.y = pack2(wap[(k0 + 2) * 64], wap[(k0 + 3) * 64]); wa_.z = pack2(wap[(k0 + 4) * 64], wap[(k0 + 5) * 64]); wa_.w = pack2(wap[(k0 + 6) * 64], wap[(k0 + 7) * 64]);
        wi_.x = pack2(wip[(k0 + 0) * 64], wip[(k0 + 1) * 64]); wi_.y = pack2(wip[(k0 + 2) * 64], wip[(k0 + 3) * 64]); wi_.z = pack2(wip[(k0 + 4) * 64], wip[(k0 + 5) * 64]); wi_.w = pack2(wip[(k0 + 6) * 64], wip[(k0 + 7) * 64]);
        wfa[kk] = __builtin_bit_cast(bf16x8, wa_); wfi[kk] = __builtin_bit_cast(bf16x8, wi_); }
    const int c = n * 64 + j;
    ba = p.in[I_LBA][(l * 2 + dir) * 256 + c]; bi = p.in[I_LBI][(l * 2 + dir) * 256 + c];
    sp = log1pf(__expf(-p.in[I_LAM][(l * 2 + dir) * 256 + c]));
}
DI void phase_gates(const Params& p, int l, LAS unsigned char* lds, int tx) {
    bf16x8 wfa[4], wfi[4]; float ba, bi, sp;
    if ((p.gx & 7) == 0) {
        const int n = (p.bx >> 1) & 3, dir = p.bx & 1;
        gates_load_w(p, l, n, dir, tx, wfa, wfi, ba, bi, sp);
        for (int u = p.bx; u < 96 * 8; u += p.gx) gates_unit(p, l, u >> 3, n, dir, lds, tx, wfa, wfi, ba, bi, sp);
    } else {
        for (int u = p.bx; u < 96 * 8; u += p.gx) { const int n = (u >> 1) & 3, dir = u & 1;
            gates_load_w(p, l, n, dir, tx, wfa, wfi, ba, bi, sp);
            gates_unit(p, l, u >> 3, n, dir, lds, tx, wfa, wfi, ba, bi, sp); }
    }
}
template <int CH, int LC> DI void scan_unit(const Params& p, int l, int sigma, int dir, int cbase, LAS unsigned char* lds, int tx) {
    constexpr int NCH = 512 / CH;
    const int tid = tx, j = tid % CH, chunk = tid / CH;
    const int S = LC * NCH, row0 = (sigma < 32) ? sigma * 256 : TC + (sigma - 32) * 1024;
    const int c = cbase + j;
    const float* __restrict__ Ab = (const float*)(p.ws + WS_R2) + (size_t)dir * T * 256 + c;
    const float* __restrict__ Bb = (const float*)(p.ws + WS_XC) + (size_t)dir * T * 256 + c;
    float* __restrict__ Hb = (float*)(p.ws + WS_HF) + (size_t)dir * T * 256 + c;
    const float h0 = (sigma < 32) ? 0.f : p.in[I_STATE][((size_t)((sigma - 32) * 2 + l) * 2 + dir) * 256 + c];
    const int tau0 = chunk * LC;
    const long step = dir ? -256 : 256;
    const long off0 = (long)(row0 + (dir ? (S - 1 - tau0) : tau0)) * 256;
    float av[LC], bv[LC];
#pragma unroll
    for (int q = 0; q < LC; ++q) { av[q] = Ab[off0 + (long)q * step]; bv[q] = Bb[off0 + (long)q * step]; }
    float H = 0.f, P = 1.f;
#pragma unroll
    for (int q = 0; q < LC; ++q) { H = av[q] * H + bv[q]; P *= av[q]; }
    LAS float* sP = (LAS float*)lds; LAS float* sH = sP + 512;
    sP[chunk * CH + j] = P; sH[chunk * CH + j] = H;
    __syncthreads();
    float h = h0;
    for (int cc = 0; cc < chunk; ++cc) h = sP[cc * CH + j] * h + sH[cc * CH + j];
#pragma unroll
    for (int q = 0; q < LC; ++q) { h = av[q] * h + bv[q]; Hb[off0 + (long)q * step] = h; }
    if (chunk == NCH - 1 && sigma < 32) p.out[OUT_ST + ((size_t)(sigma * 2 + l) * 2 + dir) * 256 + c] = h;
    __syncthreads();
}
DI void phase_scan(const Params& p, int l, LAS unsigned char* lds, int tx) {
    for (int u = p.bx; u < 320; u += p.gx) {
        if (u < 64) scan_unit<32, 64>(p, l, 32 + (u >> 4), (u >> 3) & 1, (u & 7) * 32, lds, tx);
        else { const int v = u - 64; scan_unit<64, 32>(p, l, v >> 3, (v >> 2) & 1, (v & 3) * 64, lds, tx); }
    }
}

DI void seq_of_row(int r, int& base, int& key, int& Sk) {
    if (r < TC) { base = (r >> 8) * 256; key = r & 255; Sk = 256; }
    else if (r < T) { const int b = (r - TC) >> 10; base = TC + b * 1280; key = (r - TC) & 1023; Sk = 1280; }
    else { const int b = (r - T) >> 8; base = TC + b * 1280; key = 1024 + ((r - T) & 255); Sk = 1280; }
}
DI void phase_qk_finalize(const Params& p, int l, LAS unsigned char* lds, int tx) {
    const int tid = tx, lane = tid & 63, wave = tid >> 6, h = lane >> 3, j = lane & 7;
    const bf16_t* __restrict__ U = (const bf16_t*)(p.ws + WS_R1);
    const bf16_t* __restrict__ QRAW = (const bf16_t*)(p.ws + WS_R3);
    const bf16_t* __restrict__ KVRAW = (const bf16_t*)(p.ws + WS_KVRAW);
    bf16_t* __restrict__ Q = (bf16_t*)(p.ws + WS_R4);
    bf16_t* __restrict__ K = (bf16_t*)(p.ws + WS_K);
    bf16_t* __restrict__ VT = (bf16_t*)(p.ws + WS_VT);
    const float* qhg = p.in[I_QHG] + l * 96; const float* khg = p.in[I_KHG] + l * 96;
    LAS bf16_t* Vs = (LAS bf16_t*)lds;
    float qg[12], kg[12];
#pragma unroll
    for (int i = 0; i < 12; ++i) { qg[i] = qhg[j + 8 * i]; kg[i] = khg[j + 8 * i]; }
    const float invf = __builtin_amdgcn_exp2f(-1.6609640474436813f * (float)j);
    for (int unit = p.bx; unit < TKV / 64; unit += p.gx) {
        const bool mainrow = (unit * 64 < T);
        for (int hb = 0; hb < 2; ++hb) {
            const int rbase = unit * 64 + wave * 8 + hb * 4;
            float qv[4][12], kv[4][12]; u32x4 vw[4];
#pragma unroll
            for (int q = 0; q < 4; ++q) { const int r = rbase + q;
                if (mainrow) {
#pragma unroll
                    for (int i = 0; i < 12; ++i) qv[q][i] = bf2f(QRAW[(size_t)r * 768 + h * 96 + j + 8 * i]);
#pragma unroll
                    for (int i = 0; i < 4; ++i) kv[q][8 + i] = bf2f(U[(size_t)r * INWP + 1664 + j + 8 * i]);
                } else { const int rc = r - T, b_ = rc >> 8, s = rc & 255;
#pragma unroll
                    for (int i = 0; i < 12; ++i) qv[q][i] = 0.f;
#pragma unroll
                    for (int i = 0; i < 4; ++i) kv[q][8 + i] = p.in[I_CKR][((size_t)(b_ * 2 + l) * 256 + s) * 32 + j + 8 * i]; }
#pragma unroll
                for (int i = 0; i < 8; ++i) kv[q][i] = bf2f(KVRAW[(size_t)r * 1024 + h * 128 + j + 8 * i]);
                vw[q] = *(const u32x4*)(KVRAW + (size_t)r * 1024 + h * 128 + 64 + j * 8);
            }
#pragma unroll
            for (int q = 0; q < 4; ++q) { const int r = rbase + q;
                int base, key, Sk; seq_of_row(r, base, key, Sk);
                const bool rope = (r >= TC && r < T);
                float c0 = 1.f, s0 = 0.f, c1 = 1.f, s1 = 0.f;
                if (rope) { const int s = (r - TC) & 1023; const float a0 = (float)(s >> 6) * invf, a1 = (float)(s & 63) * invf; c0 = __cosf(a0); s0 = __sinf(a0); c1 = __cosf(a1); s1 = __sinf(a1); }
                float sq = 0.f, sk = 0.f;
#pragma unroll
                for (int i = 0; i < 12; ++i) { sq += qv[q][i] * qv[q][i]; sk += kv[q][i] * kv[q][i]; }
                sq += __shfl_xor(sq, 1); sk += __shfl_xor(sk, 1); sq += __shfl_xor(sq, 2); sk += __shfl_xor(sk, 2); sq += __shfl_xor(sq, 4); sk += __shfl_xor(sk, 4);
                const float iq = rsqrtf(sq * (1.0f / 96.0f) + EPS) * QSCALE, ik = rsqrtf(sk * (1.0f / 96.0f) + EPS);
#pragma unroll
                for (int i = 0; i < 12; ++i) { qv[q][i] = qv[q][i] * iq * qg[i]; kv[q][i] = kv[q][i] * ik * kg[i]; }
                if (rope) {
                    { const float x1 = qv[q][8], x2 = qv[q][9], x3 = qv[q][10], x4 = qv[q][11];
                      qv[q][8] = x1 * c0 - x2 * s0; qv[q][9] = x2 * c0 + x1 * s0; qv[q][10] = x3 * c1 - x4 * s1; qv[q][11] = x4 * c1 + x3 * s1; }
                    { const float x1 = kv[q][8], x2 = kv[q][9], x3 = kv[q][10], x4 = kv[q][11];
                      kv[q][8] = x1 * c0 - x2 * s0; kv[q][9] = x2 * c0 + x1 * s0; kv[q][10] = x3 * c1 - x4 * s1; kv[q][11] = x4 * c1 + x3 * s1; }
                }
                if (mainrow) {
#pragma unroll
                    for (int i = 0; i < 12; ++i) Q[((size_t)r * 8 + h) * 96 + j + 8 * i] = (bf16_t)(pack2(qv[q][i], 0.f) & 0xffffu);
                }
                bf16_t* kd = K + ((size_t)base * 8 + (size_t)h * Sk + key) * 96;
#pragma unroll
                for (int i = 0; i < 12; ++i) kd[j + 8 * i] = (bf16_t)(pack2(kv[q][i], 0.f) & 0xffffu);
                *(LAS u32x4*)(Vs + (wave * 8 + hb * 4 + q) * 520 + lane * 8) = vw[q];
            }
        }
        __syncthreads();
        {
            int base, key, Sk; seq_of_row(unit * 64, base, key, Sk);
            const int hh = tid >> 6, d = tid & 63;
            bf16_t* vd = VT + ((size_t)base * 8 + (size_t)hh * Sk) * 64 + (size_t)d * Sk + key;
#pragma unroll
            for (int q = 0; q < 8; ++q) { u32x4 w;
                w.x = (unsigned)Vs[(q * 8 + 0) * 520 + tid] | ((unsigned)Vs[(q * 8 + 1) * 520 + tid] << 16);
                w.y = (unsigned)Vs[(q * 8 + 2) * 520 + tid] | ((unsigned)Vs[(q * 8 + 3) * 520 + tid] << 16);
                w.z = (unsigned)Vs[(q * 8 + 4) * 520 + tid] | ((unsigned)Vs[(q * 8 + 5) * 520 + tid] << 16);
                w.w = (unsigned)Vs[(q * 8 + 6) * 520 + tid] | ((unsigned)Vs[(q * 8 + 7) * 520 + tid] << 16);
                *(u32x4*)(vd + q * 8) = w; }
        }
        __syncthreads();
    }
}

DI void attn_unit(const Params& p, int base, int Sk, int h, int qrow0, LAS unsigned char* lds, int tx, float negmB) {
    const int tid = tx, lane = tid & 63, wave = tid >> 6, grp = wave >> 2, wq = wave & 3, r32 = lane & 31, half = lane >> 5, gt = tid & 255;
    const bf16_t* __restrict__ Q = (const bf16_t*)(p.ws + WS_R4);
    const bf16_t* __restrict__ Kg = (const bf16_t*)(p.ws + WS_K) + ((size_t)base * 8 + (size_t)h * Sk) * 96;
    const bf16_t* __restrict__ Vg = (const bf16_t*)(p.ws + WS_VT) + ((size_t)base * 8 + (size_t)h * Sk) * 64;
    bf16_t* __restrict__ O = (bf16_t*)(p.ws + WS_R3);
    LAS unsigned char* Ks = lds + grp * 22528;
    LAS unsigned char* Vs = Ks + 13312;
    const int qrow = qrow0 + wq * 32 + r32;
    bf16x8 Qf[6];
#pragma unroll
    for (int kk = 0; kk < 6; ++kk) Qf[kk] = *(const bf16x8*)(Q + ((size_t)qrow * 8 + h) * 96 + 16 * kk + 8 * half);
    int kr[3], kcc[3], vd[2], vcc[2];
#pragma unroll
    for (int i = 0; i < 3; ++i) { const int c = gt + 256 * i; kr[i] = c / 12; kcc[i] = c % 12; }
#pragma unroll
    for (int i = 0; i < 2; ++i) { const int c = gt + 256 * i; vd[i] = c >> 3; vcc[i] = c & 7; }
    f32x16 o0, o1;
#pragma unroll
    for (int i = 0; i < 16; ++i) { o0[i] = 0.f; o1[i] = 0.f; }
    float lsum = 0.f;
    const int nit = Sk >> 7;
    u32x4 kreg[3], vreg[2];
    {   const bf16_t* kn = Kg + (size_t)grp * 64 * 96;
#pragma unroll
        for (int i = 0; i < 3; ++i) kreg[i] = *(const u32x4*)(kn + (size_t)kr[i] * 96 + kcc[i] * 8);
#pragma unroll
        for (int i = 0; i < 2; ++i) vreg[i] = *(const u32x4*)(Vg + (size_t)vd[i] * Sk + grp * 64 + vcc[i] * 8); }
    for (int it = 0; it < nit; ++it) {
        __syncthreads();
#pragma unroll
        for (int i = 0; i < 3; ++i) *(LAS u32x4*)(Ks + kr[i] * 208 + kcc[i] * 16) = kreg[i];
#pragma unroll
        for (int i = 0; i < 2; ++i) *(LAS u32x4*)(Vs + vd[i] * 144 + vcc[i] * 16) = vreg[i];
        __syncthreads();
        if (it + 1 < nit) {
            const int kt = 2 * (it + 1) + grp;
            const bf16_t* kn = Kg + (size_t)kt * 64 * 96;
#pragma unroll
            for (int i = 0; i < 3; ++i) kreg[i] = *(const u32x4*)(kn + (size_t)kr[i] * 96 + kcc[i] * 8);
#pragma unroll
            for (int i = 0; i < 2; ++i) vreg[i] = *(const u32x4*)(Vg + (size_t)vd[i] * Sk + kt * 64 + vcc[i] * 8);
        }
        f32x16 s0, s1;
#pragma unroll
        for (int i = 0; i < 16; ++i) { s0[i] = negmB; s1[i] = negmB; }
#pragma unroll
        for (int kk = 0; kk < 6; ++kk) { const bf16x8 a0 = *(const LAS bf16x8*)(Ks + r32 * 208 + (16 * kk + 8 * half) * 2); s0 = MFMA32(a0, Qf[kk], s0); }
#pragma unroll
        for (int kk = 0; kk < 6; ++kk) { const bf16x8 a1 = *(const LAS bf16x8*)(Ks + (32 + r32) * 208 + (16 * kk + 8 * half) * 2); s1 = MFMA32(a1, Qf[kk], s1); }
        float ps = 0.f;
#pragma unroll
        for (int i = 0; i < 16; ++i) { s0[i] = __builtin_amdgcn_exp2f(s0[i]); ps += s0[i]; }
#pragma unroll
        for (int s = 0; s < 2; ++s) {
            u32x4 pw; pw.x = pack2(s0[8 * s], s0[8 * s + 1]); pw.y = pack2(s0[8 * s + 2], s0[8 * s + 3]); pw.z = pack2(s0[8 * s + 4], s0[8 * s + 5]); pw.w = pack2(s0[8 * s + 6], s0[8 * s + 7]);
            const bf16x8 pb = __builtin_bit_cast(bf16x8, pw);
            const int koff = (16 * s + 4 * half) * 2;
            const s16x4 v0lo = *(const LAS s16x4*)(Vs + r32 * 144 + koff), v0hi = *(const LAS s16x4*)(Vs + r32 * 144 + koff + 16);
            const s16x4 v1lo = *(const LAS s16x4*)(Vs + (32 + r32) * 144 + koff), v1hi = *(const LAS s16x4*)(Vs + (32 + r32) * 144 + koff + 16);
            const bf16x8 va0 = __builtin_shufflevector(v0lo, v0hi, 0, 1, 2, 3, 4, 5, 6, 7), va1 = __builtin_shufflevector(v1lo, v1hi, 0, 1, 2, 3, 4, 5, 6, 7);
            o0 = MFMA32(va0, pb, o0); o1 = MFMA32(va1, pb, o1);
        }
#pragma unroll
        for (int i = 0; i < 16; ++i) { s1[i] = __builtin_amdgcn_exp2f(s1[i]); ps += s1[i]; }
        lsum += ps;
#pragma unroll
        for (int s = 0; s < 2; ++s) {
            u32x4 pw; pw.x = pack2(s1[8 * s], s1[8 * s + 1]); pw.y = pack2(s1[8 * s + 2], s1[8 * s + 3]); pw.z = pack2(s1[8 * s + 4], s1[8 * s + 5]); pw.w = pack2(s1[8 * s + 6], s1[8 * s + 7]);
            const bf16x8 pb = __builtin_bit_cast(bf16x8, pw);
            const int koff = (32 + 16 * s + 4 * half) * 2;
            const s16x4 v0lo = *(const LAS s16x4*)(Vs + r32 * 144 + koff), v0hi = *(const LAS s16x4*)(Vs + r32 * 144 + koff + 16);
            const s16x4 v1lo = *(const LAS s16x4*)(Vs + (32 + r32) * 144 + koff), v1hi = *(const LAS s16x4*)(Vs + (32 + r32) * 144 + koff + 16);
            const bf16x8 va0 = __builtin_shufflevector(v0lo, v0hi, 0, 1, 2, 3, 4, 5, 6, 7), va1 = __builtin_shufflevector(v1lo, v1hi, 0, 1, 2, 3, 4, 5, 6, 7);
            o0 = MFMA32(va0, pb, o0); o1 = MFMA32(va1, pb, o1);
        }
    }
    lsum += __shfl_xor(lsum, 32);
    LAS float* cb = (LAS float*)lds + (size_t)(wq * 34) * 64 + lane;
    __syncthreads();
    if (grp == 1) {
#pragma unroll
        for (int i = 0; i < 16; ++i) { cb[i * 64] = o0[i]; cb[(16 + i) * 64] = o1[i]; }
        cb[33 * 64] = lsum;
    }
    __syncthreads();
    if (grp == 0) {
        const float inv = 1.0f / (lsum + cb[33 * 64]);
        const float w0 = inv, w1 = inv;
        bf16_t* orow = O + (size_t)qrow * 512 + h * 64 + 4 * half;
#pragma unroll
        for (int g = 0; g < 4; ++g) {
            f32x4 a = {o0[4 * g] * w0 + cb[(4 * g) * 64] * w1, o0[4 * g + 1] * w0 + cb[(4 * g + 1) * 64] * w1, o0[4 * g + 2] * w0 + cb[(4 * g + 2) * 64] * w1, o0[4 * g + 3] * w0 + cb[(4 * g + 3) * 64] * w1};
            f32x4 b = {o1[4 * g] * w0 + cb[(16 + 4 * g) * 64] * w1, o1[4 * g + 1] * w0 + cb[(16 + 4 * g + 1) * 64] * w1, o1[4 * g + 2] * w0 + cb[(16 + 4 * g + 2) * 64] * w1, o1[4 * g + 3] * w0 + cb[(16 + 4 * g + 3) * 64] * w1};
            u32x2 wa_, wb_; wa_.x = pack2(a[0], a[1]); wa_.y = pack2(a[2], a[3]); wb_.x = pack2(b[0], b[1]); wb_.y = pack2(b[2], b[3]);
            *(u32x2*)(orow + 8 * g) = wa_; *(u32x2*)(orow + 32 + 8 * g) = wb_;
        }
    }
}
DI void attn_dispatch(const Params& p, int u, LAS unsigned char* lds, int tx, float negmB) {
    if (u < 256) { const int b = u >> 6, h = (u >> 3) & 7, qb = u & 7; attn_unit(p, TC + b * 1280, 1280, h, TC + b * 1024 + qb * 128, lds, tx, negmB); }
    else { const int v = u - 256, sg = v >> 4, h = (v >> 1) & 7, hf = v & 1; attn_unit(p, sg * 256, 256, h, sg * 256 + hf * 128, lds, tx, negmB); }
}
DI void phase_attn(const Params& p, int l, LAS unsigned char* lds, int tx) {
    const int G = p.gx, b = p.bx;
    float gq = 0.f, gk = 0.f;
    for (int i = 0; i < 96; ++i) { gq = fmaxf(gq, fabsf(p.in[I_QHG][l * 96 + i])); gk = fmaxf(gk, fabsf(p.in[I_KHG][l * 96 + i])); }
    const float negmB = -fminf((96.0f * QSCALE) * gq * gk * 1.01f, 64.0f);
    if (G == 256) {
        const int x = b & 7, j = b >> 3, pair = x * 4 + (j >> 3), ul = (pair >> 3) * 64 + (pair & 7) * 8 + (j & 7);
        attn_dispatch(p, ul, lds, tx, negmB); attn_dispatch(p, 256 + 2 * b, lds, tx, negmB); attn_dispatch(p, 256 + 2 * b + 1, lds, tx, negmB); }
    else { for (int u = b; u < 768; u += G) attn_dispatch(p, u, lds, tx, negmB); }
}

DI float gelu_tanh(float x) { const float u = 0.7978845608028654f * (x + 0.044715f * x * x * x); const float e = __expf(2.0f * u); const float t = 1.0f - 2.0f / (e + 1.0f); return 0.5f * x * (1.0f + t); }
struct MixRow { u32x2 cg[3], hh[3], bg, yb, p0, p1; f32x4 hf, hb; };
DI MixRow mix_load(const bf16_t* __restrict__ U, const float* __restrict__ HF, const float* __restrict__ HB, const bf16_t* __restrict__ O, int r, int c) {
    MixRow m;
    const int s = (r < TC) ? (r & 255) : ((r - TC) & 1023), S = (r < TC) ? 256 : 1024;
#pragma unroll
    for (int k = 0; k < 3; ++k) { const int sk = s + k - 1; const bool ok = (sk >= 0 && sk < S); const bf16_t* u = U + (size_t)(r + (ok ? k - 1 : 0)) * INWP;
        const u32x2 z = {0u, 0u}; const u32x2 a = *(const u32x2*)(u + 256 + c), b = *(const u32x2*)(u + 512 + c); m.cg[k] = ok ? a : z; m.hh[k] = ok ? b : z; }
    m.bg = *(const u32x2*)(U + (size_t)r * INWP + c); m.yb = *(const u32x2*)(U + (size_t)r * INWP + 1024 + c);
    m.hf = *(const f32x4*)(HF + (size_t)r * 256 + c); m.hb = *(const f32x4*)(HB + (size_t)r * 256 + c);
    m.p0 = *(const u32x2*)(O + (size_t)r * 512 + c); m.p1 = *(const u32x2*)(O + (size_t)r * 512 + 256 + c);
    return m;
}
DI void mix_store(const MixRow& m, bf16_t* __restrict__ Y, int r, int c, const f32x4 (&wv)[3], const f32x4& cbv, const f32x4& gcv, const f32x4& glv, const f32x4& gm0, const f32x4& gm1) {
    const f32x4 o0 = {bflo(m.p0.x), bfhi(m.p0.x), bflo(m.p0.y), bfhi(m.p0.y)}, o1 = {bflo(m.p1.x), bfhi(m.p1.x), bflo(m.p1.y), bfhi(m.p1.y)};
    f32x4 acc = cbv;
#pragma unroll
    for (int k = 0; k < 3; ++k) { acc[0] += wv[k][0] * (bflo(m.cg[k].x) * bflo(m.hh[k].x)); acc[1] += wv[k][1] * (bfhi(m.cg[k].x) * bfhi(m.hh[k].x));
        acc[2] += wv[k][2] * (bflo(m.cg[k].y) * bflo(m.hh[k].y)); acc[3] += wv[k][3] * (bfhi(m.cg[k].y) * bfhi(m.hh[k].y)); }
    const f32x4 y1 = {bflo(m.bg.x) * acc[0], bfhi(m.bg.x) * acc[1], bflo(m.bg.y) * acc[2], bfhi(m.bg.y) * acc[3]};
    const f32x4 y2 = {(m.hf[0] + m.hb[0]) * gelu_tanh(bflo(m.yb.x)), (m.hf[1] + m.hb[1]) * gelu_tanh(bfhi(m.yb.x)), (m.hf[2] + m.hb[2]) * gelu_tanh(bflo(m.yb.y)), (m.hf[3] + m.hb[3]) * gelu_tanh(bfhi(m.yb.y))};
    float s1 = y1[0] * y1[0] + y1[1] * y1[1] + y1[2] * y1[2] + y1[3] * y1[3];
    float s2 = y2[0] * y2[0] + y2[1] * y2[1] + y2[2] * y2[2] + y2[3] * y2[3];
    float s3 = o0[0] * o0[0] + o0[1] * o0[1] + o0[2] * o0[2] + o0[3] * o0[3] + o1[0] * o1[0] + o1[1] * o1[1] + o1[2] * o1[2] + o1[3] * o1[3];
#pragma unroll
    for (int o = 32; o >= 1; o >>= 1) { s1 += __shfl_xor(s1, o); s2 += __shfl_xor(s2, o); s3 += __shfl_xor(s3, o); }
    const float i1 = rsqrtf(s1 * (1.0f / 256.0f) + EPS), i2 = rsqrtf(s2 * (1.0f / 256.0f) + EPS), i3 = rsqrtf(s3 * (1.0f / 512.0f) + EPS);
    u32x2 o;
    o.x = pack2(y1[0] * i1 * gcv[0], y1[1] * i1 * gcv[1]); o.y = pack2(y1[2] * i1 * gcv[2], y1[3] * i1 * gcv[3]); *(u32x2*)(Y + (size_t)r * D + c) = o;
    o.x = pack2(y2[0] * i2 * glv[0], y2[1] * i2 * glv[1]); o.y = pack2(y2[2] * i2 * glv[2], y2[3] * i2 * glv[3]); *(u32x2*)(Y + (size_t)r * D + 256 + c) = o;
    o.x = pack2(o0[0] * i3 * gm0[0], o0[1] * i3 * gm0[1]); o.y = pack2(o0[2] * i3 * gm0[2], o0[3] * i3 * gm0[3]); *(u32x2*)(Y + (size_t)r * D + 512 + c) = o;
    o.x = pack2(o1[0] * i3 * gm1[0], o1[1] * i3 * gm1[1]); o.y = pack2(o1[2] * i3 * gm1[2], o1[3] * i3 * gm1[3]); *(u32x2*)(Y + (size_t)r * D + 768 + c) = o;
}
DI void phase_mix_finalize(const Params& p, int l, int tx, int rlo = 0, int rhi = T) {
    const int lane = tx & 63, wave = tx >> 6, c = 4 * lane;
    const bf16_t* __restrict__ U = (const bf16_t*)(p.ws + WS_R1);
    const float* __restrict__ HF = (const float*)(p.ws + WS_HF); const float* __restrict__ HB = HF + (size_t)T * 256;
    const bf16_t* __restrict__ O = (const bf16_t*)(p.ws + WS_R3);
    bf16_t* __restrict__ Y = (bf16_t*)(p.ws + WS_R2);
    const float* cw = p.in[I_CONVW] + l * 3 * 256;
    f32x4 wv[3];
#pragma unroll
    for (int k = 0; k < 3; ++k) wv[k] = *(const f32x4*)(cw + k * 256 + c);
    const f32x4 cbv = *(const f32x4*)(p.in[I_CONVB] + l * 256 + c), gcv = *(const f32x4*)(p.in[I_GNC] + l * 256 + c), glv = *(const f32x4*)(p.in[I_GNL] + l * 256 + c);
    const f32x4 gm0 = *(const f32x4*)(p.in[I_GNM] + l * 512 + c), gm1 = *(const f32x4*)(p.in[I_GNM] + l * 512 + 256 + c);
    for (int rb = rlo + (p.bx * 8 + wave) * 2; rb < rhi; rb += p.gx * 8 * 2) {
        const MixRow m0 = mix_load(U, HF, HB, O, rb, c), m1 = mix_load(U, HF, HB, O, rb + 1, c);
        mix_store(m0, Y, rb, c, wv, cbv, gcv, glv, gm0, gm1);
        mix_store(m1, Y, rb + 1, c, wv, cbv, gcv, glv, gm0, gm1);
    }
}

#define XB_TMO      128
#define XB_XCNT(j)  (256  + 64 * (j))
#define XB_XSUB(j)  (1280 + 64 * (j))
#define XB_XGEN(j)  (2304 + 64 * (j))
#define XB_TOP      3328
#define XB_TOPGEN   3392
#define XCD_BAR_WORDS 3456
#define XB_SPIN_CAP (1u << 18)
__device__ __forceinline__ unsigned xb_ld(unsigned* p)              { return __hip_atomic_load(p, __ATOMIC_RELAXED, __HIP_MEMORY_SCOPE_AGENT); }
__device__ __forceinline__ unsigned xb_add(unsigned* p, unsigned v) { return __hip_atomic_fetch_add(p, v, __ATOMIC_RELAXED, __HIP_MEMORY_SCOPE_AGENT); }
__device__ __forceinline__ unsigned xb_xcc_id() { return (unsigned)__builtin_amdgcn_s_getreg((3 << 11) | 20) & 0xFu; }
#define XB_SPIN(cond, bar) do { unsigned _sp = 0; while (cond) { __builtin_amdgcn_s_sleep(1); \
    if ((++_sp & 255u) == 0u) { if (xb_ld(&(bar)[XB_TMO])) break; if (_sp > XB_SPIN_CAP) { atomicAdd(&(bar)[XB_TMO], 1u); break; } } } } while (0)

struct XcdBarrier {
    unsigned* bar; unsigned x;
    volatile LAS unsigned* st;
};

__device__ __forceinline__ XcdBarrier xcd_barrier_post(unsigned* bar, volatile LAS unsigned* st) {
    XcdBarrier b; b.bar = bar; b.x = xb_xcc_id(); b.st = st;
    if (threadIdx.x == 0) (void)xb_add(&bar[XB_XCNT(b.x)], 1u);
    return b;
}
__device__ __forceinline__ void xcd_barrier_complete(unsigned* bar, unsigned x, unsigned& nloc, unsigned& nx) {
    const unsigned G = gridDim.x * gridDim.y * gridDim.z;
    unsigned sum, cnt, mine, sp = 0u;
    for (;;) {
        sum = 0u; cnt = 0u; mine = 0u;
#pragma unroll
        for (unsigned j = 0; j < 16; ++j) { const unsigned c = xb_ld(&bar[XB_XCNT(j)]); sum += c; cnt += (c > 0u) ? 1u : 0u; mine = (j == x) ? c : mine; }
        if (sum == G) break;
        __builtin_amdgcn_s_sleep(1);
        if ((++sp & 255u) == 0u) { if (xb_ld(&bar[XB_TMO])) break; if (sp > XB_SPIN_CAP) { atomicAdd(&bar[XB_TMO], 1u); break; } }
    }
    nloc = mine > 0u ? mine : 1u; nx = cnt > 0u ? cnt : 1u;
}

__device__ __forceinline__ void xcd_barrier(const XcdBarrier& b) {
    asm volatile("s_waitcnt vmcnt(0)" ::: "memory");
    __syncthreads();
    if (threadIdx.x == 0) {
        unsigned* bar = b.bar;
        __builtin_amdgcn_s_waitcnt(0);
        unsigned nloc = b.st[0], nx = b.st[1];
        if (nloc == 0u) { xcd_barrier_complete(bar, b.x, nloc, nx); b.st[0] = nloc; b.st[1] = nx; }
        const unsigned old = xb_add(&bar[XB_XSUB(b.x)], 1u);
        const unsigned gen = old / nloc;
        if (old + 1u == (gen + 1u) * nloc) {
            __builtin_amdgcn_fence(__ATOMIC_RELEASE, "agent");
            asm volatile("s_waitcnt vmcnt(0)" ::: "memory");
            const unsigned og = xb_add(&bar[XB_TOP], 1u);
            const unsigned tg = og / nx;
            if (og + 1u == (tg + 1u) * nx) xb_add(&bar[XB_TOPGEN], 1u);
            else XB_SPIN(xb_ld(&bar[XB_TOPGEN]) == tg, bar);
            __builtin_amdgcn_fence(__ATOMIC_ACQUIRE, "agent");
            xb_add(&bar[XB_XGEN(b.x)], 1u);
            asm volatile("s_waitcnt vmcnt(0)" ::: "memory");
        } else {
            XB_SPIN(xb_ld(&bar[XB_XGEN(b.x)]) == gen, bar);
            __builtin_amdgcn_fence(__ATOMIC_ACQUIRE, "agent");
            asm volatile("s_waitcnt vmcnt(0)" ::: "memory");
        }
    }
    __syncthreads();
}

struct EpiResGate {
    static constexpr bool PERM = true, AFTER_DRAIN = false;
    const float* xa; const float* xb; float* out; const float* gate;
    __device__ __forceinline__ void operator()(const pg8::f32x4 (&acc)[2][2][4][2], const pg8::Unit& u, int wr, int wc, int fr, int fq) const {
        const int row0 = u.pm * 256 + wr * 64 + fr, col0 = u.pn * 256 + wc * 32 + 8 * fq;
        const int ci = (u.pm < 32) ? 0 : 1 + ((u.pm - 32) >> 2);
        const float* __restrict__ xin = (u.pm < 32) ? xa : (xb - (size_t)TC * D);
        float* __restrict__ o = out;
        pg8::f32x4 gv[2][2];
#pragma unroll
        for (int bj = 0; bj < 2; ++bj)
#pragma unroll
            for (int n = 0; n < 2; ++n) gv[bj][n] = *(const pg8::f32x4*)(gate + ci * 6144 + col0 + bj * 128 + 4 * n);
#pragma unroll
        for (int ai = 0; ai < 2; ++ai) {
            pg8::f32x4 xv[4][2][2];
#pragma unroll
            for (int m = 0; m < 4; ++m) { const size_t off = (size_t)(row0 + ai * 128 + m * 16) * D + col0;
#pragma unroll
                for (int bj = 0; bj < 2; ++bj)
#pragma unroll
                    for (int n = 0; n < 2; ++n) xv[m][bj][n] = *(const pg8::f32x4*)(xin + off + bj * 128 + 4 * n); }
            asm volatile("" ::: "memory");
#pragma unroll
            for (int m = 0; m < 4; ++m) { const size_t off = (size_t)(row0 + ai * 128 + m * 16) * D + col0;
#pragma unroll
                for (int bj = 0; bj < 2; ++bj)
#pragma unroll
                    for (int n = 0; n < 2; ++n) *(pg8::f32x4*)(o + off + bj * 128 + 4 * n) = xv[m][bj][n] + gv[bj][n] * acc[ai][bj][m][n]; }
            asm volatile("" ::: "memory");
        }
    }
};
struct EpiSwiGLU {
    static constexpr bool PERM = false, AFTER_DRAIN = false;
    bf16_t* G;
    __device__ __forceinline__ void operator()(const pg8::f32x4 (&acc)[2][2][4][2], const pg8::Unit& u, int wr, int wc, int fr, int fq) const {
        const int row0 = u.pm * 256 + wr * 64 + fr, colg0 = u.pn * 128 + wc * 16 + 4 * fq;
#pragma unroll
        for (int ai = 0; ai < 2; ++ai)
#pragma unroll
            for (int m = 0; m < 4; ++m) { bf16_t* rowp = G + (size_t)(row0 + ai * 128 + m * 16) * FF + colg0;
#pragma unroll
                for (int bj = 0; bj < 2; ++bj) { const pg8::f32x4 g = acc[ai][bj][m][0], up = acc[ai][bj][m][1];
                    float y[4];
#pragma unroll
                    for (int i = 0; i < 4; ++i) y[i] = g[i] / (1.0f + __expf(-g[i])) * up[i];
                    u32x2 w; w.x = pack2(y[0], y[1]); w.y = pack2(y[2], y[3]);
                    *(u32x2*)(rowp + bj * 64) = w; } }
    }
};

DI int cond_of_pm(int pm) { return (pm < 32) ? 0 : 1 + ((pm - 32) >> 2); }
struct EpiIn {
    static constexpr bool PERM = true, AFTER_DRAIN = false;
    bf16_t* O; const float* rs; const float* bias;
    __device__ __forceinline__ void operator()(const pg8::f32x4 (&acc)[2][2][4][2], const pg8::Unit& u, int wr, int wc, int fr, int fq) const {
        const int row0 = u.pm * 256 + wr * 64 + fr, col0 = u.pn * 256 + wc * 32 + 8 * fq;
        const float* bp = bias + cond_of_pm(u.pm) * INWP + col0;
        pg8::f32x4 bv[2][2]; float inv[2][4];
#pragma unroll
        for (int bj = 0; bj < 2; ++bj)
#pragma unroll
            for (int n = 0; n < 2; ++n) bv[bj][n] = *(const pg8::f32x4*)(bp + bj * 128 + 4 * n);
#pragma unroll
        for (int ai = 0; ai < 2; ++ai)
#pragma unroll
            for (int m = 0; m < 4; ++m) inv[ai][m] = rs[row0 + ai * 128 + m * 16];
#pragma unroll
        for (int ai = 0; ai < 2; ++ai)
#pragma unroll
            for (int m = 0; m < 4; ++m) { const float iv = rsqrtf(inv[ai][m] * (1.0f / 1024.0f) + EPS); bf16_t* rowp = O + (size_t)(row0 + ai * 128 + m * 16) * INWP + col0;
#pragma unroll
                for (int bj = 0; bj < 2; ++bj) { const pg8::f32x4 v0 = acc[ai][bj][m][0] * iv + bv[bj][0], v1 = acc[ai][bj][m][1] * iv + bv[bj][1];
                    u32x4 w; w.x = pack2(v0[0], v0[1]); w.y = pack2(v0[2], v0[3]); w.z = pack2(v1[0], v1[1]); w.w = pack2(v1[2], v1[3]);
                    *(u32x4*)(rowp + bj * 128) = w; } }
    }
};
struct EpiSwiGLU2 {
    static constexpr bool PERM = true, AFTER_DRAIN = false;
    bf16_t* G; const float* rs; const float* bias;
    __device__ __forceinline__ void operator()(const pg8::f32x4 (&acc)[2][2][4][2], const pg8::Unit& u, int wr, int wc, int fr, int fq) const {
        const int row0 = u.pm * 256 + wr * 64 + fr, colg0 = u.pn * 128 + wc * 32 + 8 * fq;
        const float* bp = bias + cond_of_pm(u.pm) * 2 * FF + u.pn * 256 + wc * 32 + 8 * fq;
        pg8::f32x4 bv[2][2]; float inv[2][4];
#pragma unroll
        for (int bj = 0; bj < 2; ++bj)
#pragma unroll
            for (int n = 0; n < 2; ++n) bv[bj][n] = *(const pg8::f32x4*)(bp + bj * 128 + 4 * n);
#pragma unroll
        for (int ai = 0; ai < 2; ++ai)
#pragma unroll
            for (int m = 0; m < 4; ++m) inv[ai][m] = rs[row0 + ai * 128 + m * 16];
#pragma unroll
        for (int ai = 0; ai < 2; ++ai)
#pragma unroll
            for (int m = 0; m < 4; ++m) { const float iv = rsqrtf(inv[ai][m] * (1.0f / 1024.0f) + EPS);
                float y[8];
#pragma unroll
                for (int n = 0; n < 2; ++n) { const pg8::f32x4 g = acc[ai][0][m][n] * iv + bv[0][n], up = acc[ai][1][m][n] * iv + bv[1][n];
#pragma unroll
                    for (int i = 0; i < 4; ++i) y[4 * n + i] = g[i] * __builtin_amdgcn_rcpf(1.0f + __builtin_amdgcn_exp2f(-1.4426950408889634f * g[i])) * up[i]; }
                u32x4 w; w.x = pack2(y[0], y[1]); w.y = pack2(y[2], y[3]); w.z = pack2(y[4], y[5]); w.w = pack2(y[6], y[7]);
                *(u32x4*)(G + (size_t)(row0 + ai * 128 + m * 16) * FF + colg0) = w; }
    }
};
struct EpiResGateN {
    static constexpr bool PERM = true, AFTER_DRAIN = false;
    const float* xa; const float* xb; float* out; const float* gate; bf16_t* An; const float* wtab; float* rs;
    __device__ __forceinline__ void operator()(const pg8::f32x4 (&acc)[2][2][4][2], const pg8::Unit& u, int wr, int wc, int fr, int fq) const {
        const int row0 = u.pm * 256 + wr * 64 + fr, col0 = u.pn * 256 + wc * 32 + 8 * fq;
        const int ci = cond_of_pm(u.pm);
        const float* __restrict__ xin = (u.pm < 32) ? xa : (xb - (size_t)TC * D);
        float* __restrict__ o = out; bf16_t* __restrict__ an = An;
        pg8::f32x4 gv[2][2], wv[2][2];
#pragma unroll
        for (int bj = 0; bj < 2; ++bj)
#pragma unroll
            for (int n = 0; n < 2; ++n) { gv[bj][n] = *(const pg8::f32x4*)(gate + ci * 6144 + col0 + bj * 128 + 4 * n); wv[bj][n] = *(const pg8::f32x4*)(wtab + ci * 1024 + col0 + bj * 128 + 4 * n); }
#pragma unroll
        for (int ai = 0; ai < 2; ++ai)
#pragma unroll
            for (int mh = 0; mh < 2; ++mh) {
                pg8::f32x4 xv[2][2][2];
#pragma unroll
                for (int mm = 0; mm < 2; ++mm) { const size_t off = (size_t)(row0 + ai * 128 + (2 * mh + mm) * 16) * D + col0;
#pragma unroll
                    for (int bj = 0; bj < 2; ++bj)
#pragma unroll
                        for (int n = 0; n < 2; ++n) xv[mm][bj][n] = *(const pg8::f32x4*)(xin + off + bj * 128 + 4 * n); }
                asm volatile("" ::: "memory");
#pragma unroll
                for (int mm = 0; mm < 2; ++mm) { const int m = 2 * mh + mm; const int row = row0 + ai * 128 + m * 16; const size_t off = (size_t)row * D + col0;
                    float ss = 0.f;
#pragma unroll
                    for (int bj = 0; bj < 2; ++bj) { u32x4 w;
#pragma unroll
                        for (int n = 0; n < 2; ++n) { const pg8::f32x4 x1 = xv[mm][bj][n] + gv[bj][n] * acc[ai][bj][m][n];
                            *(pg8::f32x4*)(o + off + bj * 128 + 4 * n) = x1;
                            ss += x1[0] * x1[0] + x1[1] * x1[1] + x1[2] * x1[2] + x1[3] * x1[3];
                            const pg8::f32x4 y = x1 * wv[bj][n];
                            if (n == 0) { w.x = pack2(y[0], y[1]); w.y = pack2(y[2], y[3]); } else { w.z = pack2(y[0], y[1]); w.w = pack2(y[2], y[3]); } }
                        *(u32x4*)(an + off + bj * 128) = w; }
                    ss += __shfl_xor(ss, 16); ss += __shfl_xor(ss, 32);
                    if (fq == 0) atomicAdd(rs + row, ss); }
                asm volatile("" ::: "memory");
            }
    }
};

struct EpiNull { static constexpr bool PERM = true, AFTER_DRAIN = false; float* sink;
    __device__ __forceinline__ void operator()(const pg8::f32x4 (&acc)[2][2][4][2], const pg8::Unit& u, int wr, int wc, int fr, int fq) const { if (acc[0][0][0][0][0] == 1.2345e37f) sink[0] = 1.f; } };
struct QKVOrder {
    int G, c;
    __device__ __forceinline__ bool next(int i, pg8::Unit& u) const {
        const int L = i * G + c;
        if (L < 144) { u.pm = L / 3; u.pn = L % 3; return true; }
        const int L2 = L - 144; if (L2 >= 208) return false;
        u.pm = 48 + (L2 >> 2); u.pn = 3 + (L2 & 3); return true;
    }
    __device__ __forceinline__ void a_ready(const pg8::Unit&) const {}
    __device__ __forceinline__ void done(const pg8::Unit&) const {}
};
struct EpiQKV {
    static constexpr bool PERM = true, AFTER_DRAIN = false;
    bf16_t* QR; bf16_t* KVR;
    __device__ __forceinline__ void operator()(const pg8::f32x4 (&acc)[2][2][4][2], const pg8::Unit& u, int wr, int wc, int fr, int fq) const {
        const bool isq = u.pn < 3;
        const int ldc = isq ? 768 : 1024;
        bf16_t* base = isq ? QR + (size_t)(u.pm * 256) * 768 + u.pn * 256 : KVR + (size_t)((u.pm - 48) * 256) * 1024 + (u.pn - 3) * 256;
        const int rowl = wr * 64 + fr, col0 = wc * 32 + 8 * fq;
#pragma unroll
        for (int ai = 0; ai < 2; ++ai)
#pragma unroll
            for (int m = 0; m < 4; ++m) { bf16_t* rowp = base + (size_t)(rowl + ai * 128 + m * 16) * ldc + col0;
#pragma unroll
                for (int bj = 0; bj < 2; ++bj) { const pg8::f32x4 v0 = acc[ai][bj][m][0], v1 = acc[ai][bj][m][1];
                    u32x4 w; w.x = pack2(v0[0], v0[1]); w.y = pack2(v0[2], v0[3]); w.z = pack2(v1[0], v1[1]); w.w = pack2(v1[2], v1[3]);
                    *(u32x4*)(rowp + bj * 128) = w; } }
    }
};
template <class Epi> DI void run_gemm(const Params& p, LAS unsigned char* lds, const bf16_t* A, const bf16_t* Bt, int M, int N, int K, const Epi& E, int tx, bool rev = false) {
    pg8::Gemm g{A, Bt, M, N, K}; pg8::StaticOrder S; S.init(M, N, p.gx, rev ? p.gx - 1 - p.bx : p.bx);
    pg8::gemm_phase<Epi, pg8::StaticOrder, false>(lds, g, S, E, nullptr, tx);
}

__global__ void __launch_bounds__(NT, 2) fwd_megakernel(KParams pk) {
    extern __shared__ __attribute__((aligned(16))) unsigned char shm[];
    LAS unsigned char* lds = (LAS unsigned char*)shm;
    cg::grid_group grid = cg::this_grid();
    const int wv64 = __builtin_amdgcn_readfirstlane((int)threadIdx.x >> 6) * 64;
    if (threadIdx.x < 4) ((LAS unsigned*)(lds + LDS_STAGE))[threadIdx.x] = 0u;
    __syncthreads();
    XcdBarrier bar = xcd_barrier_post((unsigned*)(pk.ws + WS_BAR), (volatile LAS unsigned*)(lds + LDS_STAGE));
    if (pk.ph_lo < 0) grid.sync();
    for (int pass = (PREFIX > 0 ? 0 : 1); pass < 2; ++pass) {
    const int ph_end = (pass == 0) ? PREFIX : pk.ph_hi;
    for (int ph = pk.ph_lo; ph < ph_end; ++ph) {
        unsigned zl = 0u; size_t zo = 0; asm volatile("" : "+v"(zl), "+s"(zo));
        int tx = wv64 + (int)__builtin_amdgcn_mbcnt_hi(~0u, __builtin_amdgcn_mbcnt_lo(~0u, zl));
        Params p; p.out = pk.out + zo; p.ws = pk.ws + zo; { int bx_ = (int)blockIdx.x, gx_ = (int)gridDim.x; asm volatile("" : "+s"(bx_), "+s"(gx_)); p.bx = bx_; p.gx = gx_; }
#pragma unroll
        for (int i = 0; i < 34; ++i) p.in[i] = pk.in[i] + zo;
        unsigned char* ws = p.ws;
        if (ph == 0) { phase_zero_rs(p, tx); REP(0, phase_mod(p, lds, tx, 0, p.bx, p.gx)); REP(1, phase_convert(p, 0, lds, tx, p.gx - 1 - p.bx, p.gx, 0, 8 * 28)); }
        else {
            const int l = (ph <= 10) ? 0 : 1, idx = (l == 0) ? ph - 1 : ph - 11;
            const int k = (l == 0) ? (idx < 8 ? idx : idx + 1) : (idx < 7 ? idx + 1 : idx + 2);
            const float* modl = (const float*)(ws + WS_MOD) + (size_t)l * 5 * 6144;
            const unsigned char* wt = ws + (l ? WS_WT2 : 0);
            const float* xa = (l == 0) ? p.in[I_XP] : p.out; const float* xb = (l == 0) ? p.in[I_XS] : p.out + (size_t)TC * D;
            float* rsb = (float*)(ws + WS_RS); const float* wtab = (const float*)(ws + WS_WTAB);
            switch (k) {
            case 0: REP(2, phase_prep0(p, xa, xb, p.in[I_N1G], modl, 1024, tx)); phase_tables(p, tx, 0); phase_bias(p, 0, p.bx, p.gx, tx, 1); break;
            case 1: { EpiIn E{(bf16_t*)(ws + WS_R1), rsb + (size_t)(2 * l) * T, (const float*)(ws + WS_BIN) + (size_t)l * 5 * INWP}; REP(10, run_gemm(p, lds, (const bf16_t*)(ws + WS_R2), (const bf16_t*)(wt + WS_WT_IN), T, INWP, 1024, E, tx));
                      if (l == 0) { const bool big = p.gx > 160;
                        if (!big || p.bx >= 80) { FRESH_TX(txc); phase_convert(p, 0, lds, txc, big ? p.bx - 80 : p.bx, big ? p.gx - 80 : p.gx, 8 * 28); } } } break;
            case 2: if (!(pass == 0 && PFLAG == 2)) { REP(3, phase_post_in(p, l, tx)); } if (!(pass == 0 && PFLAG == 1)) { REP(9, phase_gates(p, l, lds, tx)); }
                    if (l == 0) { FRESH_TX(txb2); phase_bias(p, 0, p.bx, p.gx, txb2, 2); } break;
            case 3: {
                REP(4, phase_scan(p, l, lds, tx));
                int k256 = 256; asm volatile("" : "+s"(k256));
                { FRESH_TX(txa); EpiQKV E{(bf16_t*)(ws + WS_R3), (bf16_t*)(ws + WS_KVRAW)}; pg8::Gemm g{(const bf16_t*)(ws + WS_R4), (const bf16_t*)(wt + WS_WT_QUP), T + TKV, INWP, k256};
                  QKVOrder S{p.gx, p.gx - 1 - p.bx}; pg8::gemm_phase<EpiQKV, QKVOrder, false>(lds, g, S, E, nullptr, txa); }
            } break;
            case 4: REP(5, phase_qk_finalize(p, l, lds, tx)); break;
            case 5: REP(6, phase_attn(p, l, lds, tx)); break;
            case 6: if ((RMASK >> 14) & 1) { phase_mix_finalize(p, l, tx, 0, T / 2); xcd_barrier(bar); phase_mix_finalize(p, l, tx, T / 2, T); } else { REP(7, phase_mix_finalize(p, l, tx)); } break;
            case 7: { if ((RMASK >> 16) & 1) { FRESH_TX(txn); EpiNull EN{(float*)(ws + WS_BAR + 8192)}; run_gemm(p, lds, (const bf16_t*)(ws + WS_R2), (const bf16_t*)(wt + WS_WT_OUT), T, 1024, 1024, EN, txn); }
                      EpiResGateN E{xa, xb, p.out, modl + 2048, (bf16_t*)(ws + WS_R3), wtab + (size_t)((l * 2 + 1) * 5) * 1024, rsb + (size_t)(2 * l + 1) * T};
                      run_gemm(p, lds, (const bf16_t*)(ws + WS_R2), (const bf16_t*)(wt + WS_WT_OUT), T, 1024, 1024, E, tx);
                      if (l == 0) { const bool big = p.gx > 224; if (!big || p.bx >= 192) { FRESH_TX(txm); phase_mod(p, lds, txm, 1, big ? p.bx - 192 : p.bx, big ? p.gx - 192 : p.gx); } } } break;
            case 9: { EpiSwiGLU2 E{(bf16_t*)(ws + WS_R1), rsb + (size_t)(2 * l + 1) * T, (const float*)(ws + WS_BGU) + (size_t)l * 5 * 2 * FF};
                      REP(11, run_gemm(p, lds, (const bf16_t*)(ws + WS_R3), (const bf16_t*)(wt + WS_WT_GU), T, 2 * FF, 1024, E, tx));
                      { const bool big = p.gx > 64;
                        if (l == 0 && (!big || p.bx >= 32)) { unsigned z2 = 0u; asm volatile("" : "+v"(z2)); const int tx2 = wv64 + (int)__builtin_amdgcn_mbcnt_hi(~0u, __builtin_amdgcn_mbcnt_lo(~0u, z2)); phase_convert(p, 1, lds, tx2, big ? p.bx - 32 : p.bx, big ? p.gx - 32 : p.gx); }
                        if (l == 0) { FRESH_TX(txt); phase_tables(p, txt, 1); } } } break;
            case 10:
                if ((RMASK >> 15) & 1) { FRESH_TX(txn); EpiNull EN{(float*)(ws + WS_BAR + 8192)}; run_gemm(p, lds, (const bf16_t*)(ws + WS_R1), (const bf16_t*)(wt + WS_WT_DN), T, 1024, FF, EN, txn); }
                if (l == 0) { EpiResGateN E{p.out, p.out + (size_t)TC * D, p.out, modl + 5120, (bf16_t*)(ws + WS_R2), wtab + (size_t)((1 * 2 + 0) * 5) * 1024, rsb + (size_t)2 * T};
                      run_gemm(p, lds, (const bf16_t*)(ws + WS_R1), (const bf16_t*)(wt + WS_WT_DN), T, 1024, FF, E, tx);
                      { const bool big = p.gx > 224; if (!big || p.bx >= 192) { unsigned z2 = 0u; asm volatile("" : "+v"(z2)); const int tx2 = wv64 + (int)__builtin_amdgcn_mbcnt_hi(~0u, __builtin_amdgcn_mbcnt_lo(~0u, z2)); phase_bias(p, 1, big ? p.bx - 192 : p.bx, big ? p.gx - 192 : p.gx, tx2); } } }
                else { EpiResGate E{p.out, p.out + (size_t)TC * D, p.out, modl + 5120}; run_gemm(p, lds, (const bf16_t*)(ws + WS_R1), (const bf16_t*)(wt + WS_WT_DN), T, 1024, FF, E, tx); }
                break;
            }
        }
        if (ph + 1 < pk.ph_hi || pass == 0) { xcd_barrier(bar); if ((RMASK >> 12) & 1) xcd_barrier(bar); }
    }
    }
}

extern "C" void kernel_launch(void* const* d_in, const int* in_sizes, int n_in, void* d_out, int out_size, void* d_ws, size_t ws_size, hipStream_t stream) {
    static int grid_blocks = 0;
    if (!grid_blocks) {
        int dev = 0, cus = 0, per_cu = 0;
        hipGetDevice(&dev);
        hipDeviceGetAttribute(&cus, hipDeviceAttributeMultiprocessorCount, dev);
        hipFuncSetAttribute((const void*)fwd_megakernel, hipFuncAttributeMaxDynamicSharedMemorySize, LDS_BYTES);
        hipOccupancyMaxActiveBlocksPerMultiprocessor(&per_cu, (const void*)fwd_megakernel, NT, LDS_BYTES);
        if (per_cu < 1) per_cu = 1;
        if (per_cu > 1) per_cu = 1;
        grid_blocks = cus * per_cu;
        if (ws_size < WS_TOTAL) fprintf(stderr, "kernel_launch: workspace too small: %zu < %zu\n", ws_size, (size_t)WS_END);
    }
    if (hipMemsetAsync((unsigned char*)d_ws + WS_BAR, 0, 16384, stream) != hipSuccess) fprintf(stderr, "memset failed\n");
    KParams p{};
    for (int i = 0; i < 34; ++i) p.in[i] = (const float*)d_in[i];
    p.out = (float*)d_out; p.ws = (unsigned char*)d_ws; p.ph_lo = 0; p.ph_hi = 20;
    void* args[] = {&p};
    hipError_t e = hipLaunchCooperativeKernel((const void*)fwd_megakernel, dim3(grid_blocks), dim3(NT), args, LDS_BYTES, stream);
    if (e != hipSuccess) fprintf(stderr, "cooperative launch failed: %s (grid %d)\n", hipGetErrorString(e), grid_blocks);
}
```
